# Optimizing an MI355X kernel written in HIP

```python
import jax, jax.numpy as jnp
from jax import lax
import numpy as np

D_MODEL = 1024
BATCH = 8
SEQ = 4096
DEPTH = 1

CONV_WIDTH = D_MODEL
CONV_KERNEL = 31
HEAD_DIM = 128
HEADS_PER_GROUP = D_MODEL // 256
DILATED_GROUPS = ((128, 1), (512, 4), (2048, 16))
N_GROUPS = len(DILATED_GROUPS)
ATTN_HEADS = HEADS_PER_GROUP * N_GROUPS
QKV_WIDTH = ATTN_HEADS * HEAD_DIM
ATTN_WIDTH = HEADS_PER_GROUP * HEAD_DIM
BLK = 128
ROPE_THETA = 10000.0
EPS = 1e-6
NEG_INF = -1e30

SPLIT_SIZES = (CONV_WIDTH, CONV_WIDTH, CONV_WIDTH,
               QKV_WIDTH, QKV_WIDTH, QKV_WIDTH,
               ATTN_WIDTH,
               D_MODEL, D_MODEL)
D_IN = sum(SPLIT_SIZES)
SPLIT_POINTS = tuple(int(v) for v in np.cumsum(SPLIT_SIZES)[:-1])

kernel_name = "hybrid_conformer_dilated_attn_block"


def rms_norm(x, w):
    xf = x.astype(jnp.float32)
    return xf * lax.rsqrt(jnp.mean(xf * xf, axis=-1, keepdims=True) + EPS) * w.astype(jnp.float32)


def layer_norm(x, w, b):
    xf = x.astype(jnp.float32)
    mu = jnp.mean(xf, axis=-1, keepdims=True)
    var = jnp.mean(jnp.square(xf - mu), axis=-1, keepdims=True)
    return (xf - mu) * lax.rsqrt(var + EPS) * w.astype(jnp.float32) + b.astype(jnp.float32)


def rope(x, positions):
    inv_freq = ROPE_THETA ** (-jnp.arange(0, HEAD_DIM, 2, dtype=jnp.float32) / HEAD_DIM)
    ang = positions.astype(jnp.float32)[..., None] * inv_freq
    cos = jnp.cos(ang)[:, :, None, :]
    sin = jnp.sin(ang)[:, :, None, :]
    xf = x.astype(jnp.float32)
    x1, x2 = xf[..., : HEAD_DIM // 2], xf[..., HEAD_DIM // 2:]
    return jnp.concatenate([x1 * cos - x2 * sin, x2 * cos + x1 * sin], axis=-1).astype(x.dtype)


def depthwise_causal_conv(u, w, b):
    out = lax.conv_general_dilated(
        u, w.astype(u.dtype)[:, None, :], window_strides=(1,),
        padding=[(CONV_KERNEL - 1, 0)], dimension_numbers=("NWC", "WIO", "NWC"),
        feature_group_count=u.shape[-1])
    return out + b.astype(u.dtype)


def dilated_window_attention(q, k, v, window, dilation):
    bsz, seq, nh, hd = q.shape
    steps = window // dilation
    span = dilation * BLK
    seq_pad = -(-seq // span) * span
    nb = seq_pad // span
    pad = ((0, 0), (0, seq_pad - seq), (0, 0), (0, 0))

    def blocks(t):
        return jnp.pad(t, pad).reshape(bsz, nb, BLK, dilation, nh, hd)

    def with_prev(t):
        prev = jnp.pad(t[:, :-1], ((0, 0), (1, 0), (0, 0), (0, 0), (0, 0), (0, 0)))
        return jnp.concatenate([prev, t], axis=2)

    qb = blocks(q)
    kk = with_prev(blocks(k))
    vv = with_prev(blocks(v))
    s = jnp.einsum("bnqrhd,bnkrhd->bnrhqk", qb, kk).astype(jnp.float32) * (hd ** -0.5)
    qi = jnp.arange(BLK)[:, None]
    kj = jnp.arange(2 * BLK)[None, :]
    diff = BLK + qi - kj
    band = (diff >= 0) & (diff <= steps)
    valid_prev = (jnp.arange(nb)[:, None, None] > 0) | (kj[None] >= BLK)
    mask = band[None] & valid_prev
    s = jnp.where(mask[:, None, None], s, NEG_INF)
    lse = jax.nn.logsumexp(s, axis=-1)
    p = jnp.exp(s - lse[..., None])
    o = jnp.einsum("bnrhqk,bnkrhd->bnqrhd", p.astype(v.dtype), vv)
    o = o.reshape(bsz, seq_pad, nh, hd)[:, :seq]
    lse = lse.transpose(0, 1, 4, 2, 3).reshape(bsz, seq_pad, nh)[:, :seq]
    return o, lse


def setup_inputs(seed: int = 0) -> dict:
    key = jax.random.key(seed)
    ks = jax.random.split(key, 17)
    f32 = jnp.float32
    nrm = lambda k, shape, s: jax.random.normal(k, shape, f32) * s
    return {
        "x": nrm(ks[0], (BATCH, SEQ, D_MODEL), 1.0),
        "c": nrm(ks[1], (BATCH, D_MODEL), 1.0),
        "positions": jnp.broadcast_to(jnp.arange(SEQ, dtype=jnp.int32), (BATCH, SEQ)),
        "norm_w": 1.0 + nrm(ks[2], (D_MODEL,), 0.02),
        "w_ada": nrm(ks[3], (D_MODEL, 3 * D_MODEL), 0.5 * D_MODEL ** -0.5),
        "b_ada": nrm(ks[4], (3 * D_MODEL,), 0.02),
        "w_in": nrm(ks[5], (D_MODEL, D_IN), D_MODEL ** -0.5),
        "conv_w": nrm(ks[6], (CONV_KERNEL, CONV_WIDTH), CONV_KERNEL ** -0.5),
        "conv_b": nrm(ks[7], (CONV_WIDTH,), 0.02),
        "conv_ln_w": 1.0 + nrm(ks[8], (CONV_WIDTH,), 0.02),
        "conv_ln_b": nrm(ks[9], (CONV_WIDTH,), 0.02),
        "w_conv_out": nrm(ks[10], (CONV_WIDTH, D_MODEL), CONV_WIDTH ** -0.5),
        "q_norm_w": 1.0 + nrm(ks[11], (HEAD_DIM,), 0.02),
        "k_norm_w": 1.0 + nrm(ks[12], (HEAD_DIM,), 0.02),
        "w_attn_out": nrm(ks[13], (ATTN_WIDTH, D_MODEL), ATTN_WIDTH ** -0.5),
        "w_out": nrm(ks[14], (D_MODEL, D_MODEL), D_MODEL ** -0.5),
    }


def reference(x, c, positions, norm_w, w_ada, b_ada, w_in, conv_w, conv_b, conv_ln_w,
              conv_ln_b, w_conv_out, q_norm_w, k_norm_w, w_attn_out, w_out):
    dt = x.dtype
    bsz, seq, _ = x.shape
    for _layer in range(DEPTH):
        mod = jax.nn.silu(c) @ w_ada + b_ada
        shift, scale, gate = jnp.split(mod, 3, axis=-1)
        h = (rms_norm(x, norm_w) * (1.0 + scale[:, None].astype(jnp.float32))
             + shift[:, None].astype(jnp.float32)).astype(dt)

        z = h @ w_in
        a, b, g_conv, q, k, v, g_attn, m_conv, m_attn = jnp.split(z, SPLIT_POINTS, axis=-1)

        u = a * jax.nn.sigmoid(b)
        u = depthwise_causal_conv(u, conv_w, conv_b)
        u = jax.nn.silu(layer_norm(u, conv_ln_w, conv_ln_b)).astype(dt)
        u = u * jax.nn.silu(g_conv)
        y_conv = u @ w_conv_out

        q = q.reshape(bsz, seq, ATTN_HEADS, HEAD_DIM)
        k = k.reshape(bsz, seq, ATTN_HEADS, HEAD_DIM)
        v = v.reshape(bsz, seq, ATTN_HEADS, HEAD_DIM)
        q = rope(rms_norm(q, q_norm_w).astype(dt), positions)
        k = rope(rms_norm(k, k_norm_w).astype(dt), positions)
        outs, lses = [], []
        for g, (window, dilation) in enumerate(DILATED_GROUPS):
            sl = slice(g * HEADS_PER_GROUP, (g + 1) * HEADS_PER_GROUP)
            o_g, l_g = dilated_window_attention(q[:, :, sl], k[:, :, sl], v[:, :, sl], window, dilation)
            outs.append(o_g)
            lses.append(l_g)
        o = jnp.stack(outs, axis=0)
        wts = jax.nn.softmax(jnp.stack(lses, axis=0), axis=0)
        o = jnp.sum(wts[..., None] * o.astype(jnp.float32), axis=0).astype(dt)
        o = o.reshape(bsz, seq, ATTN_WIDTH) * jax.nn.silu(g_attn)
        y_attn = o @ w_attn_out

        y = jax.nn.sigmoid(m_conv) * y_conv + jax.nn.sigmoid(m_attn) * y_attn
        out = y @ w_out
        x = (x + gate[:, None] * out).astype(dt)
    return x
```

```cpp
#include <hip/hip_runtime.h>
#include <hip/hip_cooperative_groups.h>
#include <cstdio>
#include <cstdint>
namespace cg = cooperative_groups;

#define LAS __attribute__((address_space(3)))
typedef unsigned short bf16_t;
typedef short bf16x8 __attribute__((ext_vector_type(8)));
typedef short s16x4 __attribute__((ext_vector_type(4)));
typedef float f32x4 __attribute__((ext_vector_type(4)));
typedef float f32x2 __attribute__((ext_vector_type(2)));
typedef unsigned u32x4 __attribute__((ext_vector_type(4)));
typedef unsigned u32x2 __attribute__((ext_vector_type(2)));

constexpr int T = 32768, DM = 1024, SEQ = 4096, NB = 8;
constexpr int QKVW = 1536;
constexpr float EPS = 1e-6f;
constexpr float LOG2E = 1.4426950408889634f;
constexpr float QSCALE = 0.08838834764831845f * 1.4426950408889634f;

constexpr size_t MiB = 1u << 20;
constexpr size_t WS_MOD = 0;
constexpr size_t WS_CTL = 768 * 1024;
constexpr size_t CTL_BYTES = 32 * 1024;
constexpr size_t WS_LSE = 1 * MiB;
constexpr size_t WS_WIN = 4 * MiB;
constexpr size_t WS_WC = 24 * MiB;
constexpr size_t WS_WA = 26 * MiB;
constexpr size_t WS_WO = 28 * MiB;
constexpr size_t WS_H = 32 * MiB;
constexpr size_t WS_A2 = 96 * MiB;
constexpr size_t WS_SMC = 160 * MiB;
constexpr size_t WS_U = 224 * MiB;
constexpr size_t WS_Q = 224 * MiB;
constexpr size_t WS_SGC = 288 * MiB;
constexpr size_t WS_SGA = 320 * MiB;
constexpr size_t WS_V = 352 * MiB;
constexpr size_t WS_SMA = 448 * MiB;
constexpr size_t WS_END = 512 * MiB;

constexpr int LDS_BYTES = 147456;
constexpr int RING_BYTES = 131072;

struct Params {
    const float *x, *c; const int* pos; const float *norm_w, *w_ada, *b_ada, *w_in, *conv_w, *conv_b, *ln_w, *ln_b, *w_conv_out, *qn_w, *kn_w, *w_attn_out, *w_out;
    float* out; unsigned char* ws;
};

typedef __bf16 bf16x2_t __attribute__((ext_vector_type(2)));
__device__ __forceinline__ unsigned cvt_pk_bf16(float lo, float hi) { f32x2 v = {lo, hi}; bf16x2_t b = __builtin_convertvector(v, bf16x2_t); return __builtin_bit_cast(unsigned, b); }
__device__ __forceinline__ float bf_lo(unsigned w) { return __builtin_bit_cast(float, w << 16); }
__device__ __forceinline__ float bf_hi(unsigned w) { return __builtin_bit_cast(float, w & 0xffff0000u); }
__device__ __forceinline__ float fast_exp2(float x) { return __builtin_amdgcn_exp2f(x); }
__device__ __forceinline__ float fast_rcp(float x) { return __builtin_amdgcn_rcpf(x); }
__device__ __forceinline__ float sigmoidf_(float x) { return fast_rcp(1.0f + fast_exp2(-x * LOG2E)); }
__device__ __forceinline__ float siluf_(float x) { return x * sigmoidf_(x); }
__device__ __forceinline__ unsigned opaque_copy(unsigned a) { unsigned b = a; asm volatile("" : "+v"(b)); return b; }
__device__ __forceinline__ float xpartner32(float v, int lane) { const unsigned a = __builtin_bit_cast(unsigned, v); const auto r = __builtin_amdgcn_permlane32_swap(a, opaque_copy(a), false, false); return __builtin_bit_cast(float, (lane & 32) ? r[0] : r[1]); }
__device__ __forceinline__ float xpartner16(float v, int lane) { const unsigned a = __builtin_bit_cast(unsigned, v); const auto r = __builtin_amdgcn_permlane16_swap(a, opaque_copy(a), false, false); return __builtin_bit_cast(float, (lane & 16) ? r[0] : r[1]); }
__device__ __forceinline__ float wave_sum(float v) {
    v += __shfl_xor(v, 32); v += __shfl_xor(v, 16); v += __shfl_xor(v, 8); v += __shfl_xor(v, 4); v += __shfl_xor(v, 2); v += __shfl_xor(v, 1); return v;
}

__device__ __forceinline__ size_t qkv_off(int b, int head, int s) {
    const int sh = 2 * (head >> 2);
    const int pos = ((s & ((1 << sh) - 1)) << (12 - sh)) | (s >> sh);
    return ((size_t)(b * 12 + head) * SEQ + pos) * 128;
}

__device__ __forceinline__ int col_of(int np) {
    if (np < 4096) {
        const int tile = np >> 8, p = np & 255;
        if (tile < 8) return (p < 128) ? (128 * tile + p) : (1024 + 128 * tile + (p - 128));
        if (tile < 12) return 2048 + 256 * (tile - 8) + p;
        return 8192 + 256 * (tile - 12) + p;
    }
    const int n2 = np - 4096, tile = n2 >> 8, p = n2 & 255;
    if (tile < 12) {
        const int head = 2 * (tile % 6) + (p >> 7), pp = p & 127;
        const int wc = pp >> 5, fq = (pp >> 3) & 3, n = (pp >> 2) & 1, j = pp & 3;
        const int d = 64 * n + 16 * wc + 4 * fq + j;
        return 3072 + (tile < 6 ? 0 : 1536) + head * 128 + d;
    }
    if (tile < 18) return 6144 + 256 * (tile - 12) + p;
    if (tile < 20) return 7680 + 256 * (tile - 18) + p;
    return 9216 + 256 * (tile - 20) + p;
}

namespace pg8 {
constexpr int BM = 256, BK = 64, HALF = 128, HTB = HALF * BK * 2, NXCD = 8, WGM = 8;
__device__ __forceinline__ int lds_byte(int r, int c) { const int st = (r >> 4) * 2 + (c >> 5), rr = r & 15, cc = c & 31, ob = rr * 64 + cc * 2; return st * 1024 + (ob ^ (((ob >> 9) & 1) << 5)); }
__device__ __forceinline__ void stage_rc(int b, int& R, int& C) { const int st = b / 1024, sb = b % 1024, swz = sb ^ (((sb >> 9) & 1) << 5); R = (st >> 1) * 16 + swz / 64; C = (st & 1) * 32 + (swz % 64) / 2; }
__device__ __forceinline__ int perm32(int rho) { const int n = rho >> 4, i = rho & 15; return 8 * (i >> 2) + 4 * n + (i & 3); }

struct Unit { int pm, pn, id; };
__device__ __forceinline__ size_t a_off(int id) { return id == 2 ? WS_A2 : (id == 3 ? WS_SGA : (id == 4 ? WS_SMC : WS_H)); }
__device__ __forceinline__ size_t b_off(int id) { return id == 0 ? WS_WIN : (id == 1 ? WS_WIN + (size_t)4096 * 1024 * 2 : (id == 2 ? WS_WC : (id == 3 ? WS_WA : WS_WO))); }
struct Sched2 {
    int mode, G, c;
    __device__ __forceinline__ bool next(int i, Unit& u) const {
        const int n0 = (mode == 0) ? 128 * 16 : 128 * 4, n1 = (mode == 1) ? 128 * 24 : 0;
        const long L = (long)i * G + c; if (L >= (long)(n0 + n1)) return false;
        const bool first = L < n0;
        const int nN = first ? ((mode == 0) ? 16 : 4) : 24;
        const int id = first ? ((mode == 0) ? 0 : (mode == 1 ? 2 : (mode == 2 ? 3 : 4))) : 1;
        int wgid = first ? (int)L : (int)L - n0; const int nwg = first ? n0 : n1;
        { const int q = nwg / NXCD, xcd = wgid % NXCD, off = wgid / NXCD; wgid = xcd * q + off; }
        const int nig = WGM * nN, gid = wgid / nig, fm = gid * WGM;
        u.pm = fm + ((wgid % nig) % WGM); u.pn = (wgid % nig) / WGM; u.id = id; return true;
    }
};
}

template <int ACT> __device__ __forceinline__ void epi_store_act(const f32x4 (&acc)[2][2][4][2], bf16_t* dst  , int ldc) {
#pragma unroll
    for (int ai = 0; ai < 2; ++ai)
#pragma unroll
        for (int m = 0; m < 4; ++m) {
            bf16_t* rowp = dst + (size_t)(ai * 128 + m * 16) * ldc;
#pragma unroll
            for (int bj = 0; bj < 2; ++bj) {
                f32x4 v0 = acc[ai][bj][m][0], v1 = acc[ai][bj][m][1];
                if (ACT == 1) { for (int j = 0; j < 4; ++j) { v0[j] = siluf_(v0[j]); v1[j] = siluf_(v1[j]); } }
                if (ACT == 2) { for (int j = 0; j < 4; ++j) { v0[j] = sigmoidf_(v0[j]); v1[j] = sigmoidf_(v1[j]); } }
                u32x4 w; w.x = cvt_pk_bf16(v0[0], v0[1]); w.y = cvt_pk_bf16(v0[2], v0[3]); w.z = cvt_pk_bf16(v1[0], v1[1]); w.w = cvt_pk_bf16(v1[2], v1[3]);
                *(u32x4*)(rowp + bj * 128) = w;
            }
        }
}

__device__ __forceinline__ void epilogue(const Params& P, const f32x4 (&acc)[2][2][4][2], const pg8::Unit& u, int wr, int wc, int fr, int fq, LAS unsigned char* lds) {
    const int row0 = u.pm * 256 + wr * 64 + fr;
    const int cw = wc * 32 + 8 * fq;
    unsigned char* ws = P.ws;
    if (u.id == 0) {
        if (u.pn < 8) {
            bf16_t* dst = (bf16_t*)(ws + WS_U) + (size_t)row0 * 1024 + u.pn * 128 + cw;
#pragma unroll
            for (int ai = 0; ai < 2; ++ai)
#pragma unroll
                for (int m = 0; m < 4; ++m) {
                    f32x4 a0 = acc[ai][0][m][0], a1 = acc[ai][0][m][1], b0 = acc[ai][1][m][0], b1 = acc[ai][1][m][1];
#pragma unroll
                    for (int j = 0; j < 4; ++j) { a0[j] *= sigmoidf_(b0[j]); a1[j] *= sigmoidf_(b1[j]); }
                    u32x4 w; w.x = cvt_pk_bf16(a0[0], a0[1]); w.y = cvt_pk_bf16(a0[2], a0[3]); w.z = cvt_pk_bf16(a1[0], a1[1]); w.w = cvt_pk_bf16(a1[2], a1[3]);
                    *(u32x4*)(dst + (size_t)(ai * 128 + m * 16) * 1024) = w;
                }
        } else if (u.pn < 12) {
            epi_store_act<1>(acc, (bf16_t*)(ws + WS_SGC) + (size_t)row0 * 1024 + (u.pn - 8) * 256 + cw, 1024);
        } else {
            epi_store_act<2>(acc, (bf16_t*)(ws + WS_SMC) + (size_t)row0 * 1024 + (u.pn - 12) * 256 + cw, 1024);
        }
    } else if (u.id == 1) {
        if (u.pn < 12) {
            const bool isq = u.pn < 6;
            LAS float* red = (LAS float*)(lds + RING_BYTES);
            float ss[2][2][4];
#pragma unroll
            for (int ai = 0; ai < 2; ++ai)
#pragma unroll
                for (int bj = 0; bj < 2; ++bj)
#pragma unroll
                    for (int m = 0; m < 4; ++m) {
                        const f32x4 a = acc[ai][bj][m][0], b = acc[ai][bj][m][1];
                        float s = (a[0] * a[0] + a[1] * a[1]) + (a[2] * a[2] + a[3] * a[3]) + (b[0] * b[0] + b[1] * b[1]) + (b[2] * b[2] + b[3] * b[3]);
                        s += xpartner16(s, fq << 4); s += xpartner32(s, fq << 4);
                        ss[ai][bj][m] = s;
                        if (fq == 0) red[(ai * 128 + wr * 64 + m * 16 + fr) * 8 + bj * 4 + wc] = s;
                    }
            asm volatile("s_waitcnt lgkmcnt(0)" ::: "memory");
            __builtin_amdgcn_s_barrier();
            asm volatile("" ::: "memory");
            const float* nw = isq ? P.qn_w : P.kn_w;
            const int d0 = 16 * wc + 4 * fq;
            const f32x4 w1 = *(const f32x4*)(nw + d0), w2 = *(const f32x4*)(nw + d0 + 64);
            float invf[4];
#pragma unroll
            for (int j = 0; j < 4; ++j) invf[j] = fast_exp2(-(float)(d0 + j) * (13.287712379549449f / 64.0f));
            const float osc = isq ? QSCALE : 1.0f;
            const int head0 = 2 * (u.pn % 6);
            bf16_t* dstb = isq ? (bf16_t*)(ws + WS_Q) : (bf16_t*)P.out;
#pragma unroll
            for (int ai = 0; ai < 2; ++ai)
#pragma unroll
                for (int m = 0; m < 4; ++m) {
                    const int row = row0 + ai * 128 + m * 16;
                    const float pos = (float)P.pos[row];
                    float cs[4], sn[4];
#pragma unroll
                    for (int j = 0; j < 4; ++j) {
                        const float ang = pos * invf[j];
                        const float k = rintf(ang * 0.15915494309189535f);
                        float r = fmaf(-k, 6.2831854820251465f, ang); r = fmaf(-k, -1.7484555e-7f, r);
                        const float rev = r * 0.15915494309189535f;
                        cs[j] = __builtin_amdgcn_cosf(rev); sn[j] = __builtin_amdgcn_sinf(rev);
                    }
#pragma unroll
                    for (int bj = 0; bj < 2; ++bj) {
                        const f32x4 t4 = *(const LAS f32x4*)(red + (ai * 128 + wr * 64 + m * 16 + fr) * 8 + bj * 4);
                        const float tot = (t4[0] + t4[1]) + (t4[2] + t4[3]);
                        const float rs = __builtin_amdgcn_rsqf(tot * (1.0f / 128.0f) + EPS) ;
                        f32x4 o1, o2;
#pragma unroll
                        for (int j = 0; j < 4; ++j) {
                            const float x1 = acc[ai][bj][m][0][j] * rs * w1[j], x2 = acc[ai][bj][m][1][j] * rs * w2[j];
                            o1[j] = (x1 * cs[j] - x2 * sn[j]) * osc; o2[j] = (x2 * cs[j] + x1 * sn[j]) * osc;
                        }
                        u32x4 w; w.x = cvt_pk_bf16(o1[0], o1[1]); w.y = cvt_pk_bf16(o1[2], o1[3]); w.z = cvt_pk_bf16(o2[0], o2[1]); w.w = cvt_pk_bf16(o2[2], o2[3]);
                        *(u32x4*)(dstb + qkv_off(row >> 12, head0 + bj, row & (SEQ - 1)) + cw) = w;
                    }
                }
            (void)ss;
        } else if (u.pn < 18) {
            bf16_t* vb = (bf16_t*)(ws + WS_V);
#pragma unroll
            for (int ai = 0; ai < 2; ++ai)
#pragma unroll
                for (int m = 0; m < 4; ++m) {
                    const int row = row0 + ai * 128 + m * 16;
#pragma unroll
                    for (int bj = 0; bj < 2; ++bj) {
                        const f32x4 v0 = acc[ai][bj][m][0], v1 = acc[ai][bj][m][1];
                        u32x4 w; w.x = cvt_pk_bf16(v0[0], v0[1]); w.y = cvt_pk_bf16(v0[2], v0[3]); w.z = cvt_pk_bf16(v1[0], v1[1]); w.w = cvt_pk_bf16(v1[2], v1[3]);
                        *(u32x4*)(vb + qkv_off(row >> 12, 2 * (u.pn - 12) + bj, row & (SEQ - 1)) + cw) = w;
                    }
                }
        } else if (u.pn < 20) {
            epi_store_act<1>(acc, (bf16_t*)(ws + WS_SGA) + (size_t)row0 * 512 + (u.pn - 18) * 256 + cw, 512);
        } else {
            epi_store_act<2>(acc, (bf16_t*)(ws + WS_SMA) + (size_t)row0 * 1024 + (u.pn - 20) * 256 + cw, 1024);
        }
    } else if (u.id == 2 || u.id == 3) {
        bf16_t* yp = (bf16_t*)(ws + WS_SMC) + (size_t)row0 * 1024 + u.pn * 256 + cw;
        const bf16_t* gp = (const bf16_t*)(ws + WS_SMA) + (size_t)row0 * 1024 + u.pn * 256 + cw;
        const bool second = (u.id == 3);
#pragma unroll
        for (int ai = 0; ai < 2; ++ai)
#pragma unroll
            for (int m = 0; m < 4; ++m)
#pragma unroll
                for (int bj = 0; bj < 2; ++bj) {
                    const size_t off = (size_t)(ai * 128 + m * 16) * 1024 + bj * 128;
                    const u32x4 y = *(const u32x4*)(yp + off);
                    const f32x4 v0 = acc[ai][bj][m][0], v1 = acc[ai][bj][m][1];
                    float r[8];
                    if (second) {
                        const u32x4 g = *(const u32x4*)(gp + off);
                        r[0] = bf_lo(y.x) + bf_lo(g.x) * v0[0]; r[1] = bf_hi(y.x) + bf_hi(g.x) * v0[1]; r[2] = bf_lo(y.y) + bf_lo(g.y) * v0[2]; r[3] = bf_hi(y.y) + bf_hi(g.y) * v0[3];
                        r[4] = bf_lo(y.z) + bf_lo(g.z) * v1[0]; r[5] = bf_hi(y.z) + bf_hi(g.z) * v1[1]; r[6] = bf_lo(y.w) + bf_lo(g.w) * v1[2]; r[7] = bf_hi(y.w) + bf_hi(g.w) * v1[3];
                    } else {
                        r[0] = bf_lo(y.x) * v0[0]; r[1] = bf_hi(y.x) * v0[1]; r[2] = bf_lo(y.y) * v0[2]; r[3] = bf_hi(y.y) * v0[3];
                        r[4] = bf_lo(y.z) * v1[0]; r[5] = bf_hi(y.z) * v1[1]; r[6] = bf_lo(y.w) * v1[2]; r[7] = bf_hi(y.w) * v1[3];
                    }
                    u32x4 w; w.x = cvt_pk_bf16(r[0], r[1]); w.y = cvt_pk_bf16(r[2], r[3]); w.z = cvt_pk_bf16(r[4], r[5]); w.w = cvt_pk_bf16(r[6], r[7]);
                    *(u32x4*)(yp + off) = w;
                }
    } else {
        const int b = u.pm >> 4;
        const float* gate = (const float*)(ws + WS_MOD) + b * 3072 + 2048 + u.pn * 256 + cw;
        const float* xp = P.x + (size_t)row0 * 1024 + u.pn * 256 + cw;
        float* op = P.out + (size_t)row0 * 1024 + u.pn * 256 + cw;
#pragma unroll
        for (int bj = 0; bj < 2; ++bj) {
            const f32x4 g0 = *(const f32x4*)(gate + bj * 128), g1 = *(const f32x4*)(gate + bj * 128 + 4);
#pragma unroll
            for (int ai = 0; ai < 2; ++ai)
#pragma unroll
                for (int m = 0; m < 4; ++m) {
                    const size_t off = (size_t)(ai * 128 + m * 16) * 1024 + bj * 128;
                    const f32x4 x0 = __builtin_nontemporal_load((const f32x4*)(xp + off)), x1 = __builtin_nontemporal_load((const f32x4*)(xp + off + 4));
                    __builtin_nontemporal_store(x0 + g0 * acc[ai][bj][m][0], (f32x4*)(op + off));
                    __builtin_nontemporal_store(x1 + g1 * acc[ai][bj][m][1], (f32x4*)(op + off + 4));
                }
        }
    }
}

namespace pg8 {
__device__ __forceinline__ void gemm_phase(const Params& P, LAS unsigned char* lds, const int K, const Sched2& S) {
    int tid = threadIdx.x; asm volatile("" : "+v"(tid));
    const int wid = __builtin_amdgcn_readfirstlane(tid >> 6), lane = tid & 63, wr = wid >> 2, wc = wid & 3, fr = lane & 15, fq = lane >> 4;
    const int nt = K / BK;
    unsigned voffA[2], voffB[2];
#pragma unroll
    for (int i = 0; i < 2; ++i) { int R, C; stage_rc(tid * 16 + i * 8192, R, C); const int Rb = (R & ~31) + perm32(R & 31);
        voffA[i] = (unsigned)(R * K + C) * 2u; voffB[i] = (unsigned)(Rb * K + C) * 2u; }
    const size_t kstep = (size_t)(BK * 2);
    const size_t hstep = (size_t)HALF * K * 2;
    const size_t tstep = 2 * hstep;
    const unsigned ldsw = (unsigned)wid * 1024u;
    const int aoff = lds_byte(wr * 64 + fr, fq * 8), boff = lds_byte(wc * 32 + fr, fq * 8);
#define PG8_SA(b, h) (((b) * 2 + (h)) * HTB)
#define PG8_SB(b, h) ((4 + (b) * 2 + (h)) * HTB)
#define PG8_STAGE(bufoff, gbase, voff) do { _Pragma("unroll") for (int _i = 0; _i < 2; ++_i) \
        __builtin_amdgcn_global_load_lds((const unsigned*)((const char*)(gbase) + (voff)[_i]), (LAS unsigned*)(lds + (bufoff) + ldsw + _i * 8192), 16, 0, 0); } while (0)
#define PG8_LDA(dst, b, h) do { _Pragma("unroll") for (int m = 0; m < 4; ++m) _Pragma("unroll") for (int k = 0; k < 2; ++k) dst[m][k] = *(const LAS bf16x8*)(lds + PG8_SA(b, h) + aoff + m * 2048 + k * 1024); } while (0)
#define PG8_LDB(dst, b, h) do { _Pragma("unroll") for (int n = 0; n < 2; ++n) _Pragma("unroll") for (int k = 0; k < 2; ++k) dst[n][k] = *(const LAS bf16x8*)(lds + PG8_SB(b, h) + boff + n * 2048 + k * 1024); } while (0)
#define PG8_MMA(ai, bj, At, Bt) do { __builtin_amdgcn_s_setprio(1); _Pragma("unroll") for (int m = 0; m < 4; ++m) _Pragma("unroll") for (int n = 0; n < 2; ++n) _Pragma("unroll") for (int k = 0; k < 2; ++k) \
        acc[ai][bj][m][n] = __builtin_amdgcn_mfma_f32_16x16x32_bf16(Bt[n][k], At[m][k], acc[ai][bj][m][n], 0, 0, 0); __builtin_amdgcn_s_setprio(0); } while (0)
#define PG8_WAIT_V(n) asm volatile("s_waitcnt vmcnt(" #n ")" ::: "memory")
#define PG8_WAIT_L(n) asm volatile("s_waitcnt lgkmcnt(" #n ")" ::: "memory")
#define PG8_BAR __builtin_amdgcn_s_barrier()
#define PG8_SCHED __builtin_amdgcn_sched_barrier(0)
    Unit cur, nxt; int ui = 0;
    if (!S.next(0, cur)) return;
    f32x4 acc[2][2][4][2];
#pragma unroll
    for (int a = 0; a < 2; ++a)
#pragma unroll
        for (int b = 0; b < 2; ++b)
#pragma unroll
            for (int m = 0; m < 4; ++m)
#pragma unroll
                for (int n = 0; n < 2; ++n) acc[a][b][m][n] = (f32x4){0.f, 0.f, 0.f, 0.f};
    bf16x8 At[4][2], B0[2][2], B1[2][2];
    const char* cA = (const char*)P.ws + a_off(cur.id) + (size_t)cur.pm * tstep; const char* cB = (const char*)P.ws + b_off(cur.id) + (size_t)cur.pn * tstep;
    PG8_STAGE(PG8_SB(0, 0), cB, voffB); PG8_STAGE(PG8_SB(0, 1), cB + hstep, voffB); PG8_STAGE(PG8_SA(0, 0), cA, voffA); PG8_STAGE(PG8_SA(0, 1), cA + hstep, voffA);
    if (wr == 1) PG8_BAR;
    PG8_WAIT_V(2); PG8_BAR;
    PG8_STAGE(PG8_SB(1, 0), cB + kstep, voffB); PG8_STAGE(PG8_SA(1, 0), cA + kstep, voffA); PG8_STAGE(PG8_SB(1, 1), cB + hstep + kstep, voffB);
    PG8_WAIT_V(6); PG8_BAR;
    for (;;) {
        const bool has_next = S.next(ui + 1, nxt);
        const char* nA = has_next ? (const char*)P.ws + a_off(nxt.id) + (size_t)nxt.pm * tstep : cA; const char* nB = has_next ? (const char*)P.ws + b_off(nxt.id) + (size_t)nxt.pn * tstep : cB;
        for (int t = 0; t < nt; t += 2) {
            const bool last = (t == nt - 2);
            const char* a1 = cA + (size_t)(t + 1) * kstep;
            const char* a2 = last ? nA : cA + (size_t)(t + 2) * kstep; const char* b2 = last ? nB : cB + (size_t)(t + 2) * kstep;
            const char* a3 = a2 + kstep; const char* b3 = b2 + kstep;
            PG8_LDB(B0, 0, 0); PG8_LDB(B1, 0, 1); PG8_SCHED; PG8_LDA(At, 0, 0); PG8_STAGE(PG8_SA(1, 1), a1 + hstep, voffA);
            PG8_WAIT_V(8); PG8_WAIT_L(0); PG8_BAR; PG8_MMA(0, 0, At, B0); PG8_MMA(0, 1, At, B1); PG8_BAR; PG8_SCHED;
            PG8_LDA(At, 0, 1); PG8_STAGE(PG8_SB(0, 0), b2, voffB); PG8_STAGE(PG8_SB(0, 1), b2 + hstep, voffB); PG8_STAGE(PG8_SA(0, 0), a2, voffA);
            PG8_WAIT_V(8); PG8_WAIT_L(0); PG8_BAR; PG8_MMA(1, 0, At, B0); PG8_MMA(1, 1, At, B1); PG8_BAR; PG8_SCHED;
            PG8_LDB(B0, 1, 0); PG8_LDB(B1, 1, 1); PG8_SCHED; PG8_LDA(At, 1, 0); PG8_STAGE(PG8_SA(0, 1), a2 + hstep, voffA);
            PG8_WAIT_V(8); PG8_WAIT_L(0); PG8_BAR; PG8_MMA(0, 0, At, B0); PG8_MMA(0, 1, At, B1); PG8_BAR; PG8_SCHED;
            PG8_LDA(At, 1, 1); PG8_STAGE(PG8_SB(1, 0), b3, voffB); PG8_STAGE(PG8_SB(1, 1), b3 + hstep, voffB); PG8_STAGE(PG8_SA(1, 0), a3, voffA);
            PG8_WAIT_V(8); PG8_WAIT_L(0); PG8_BAR; PG8_MMA(1, 0, At, B0); PG8_MMA(1, 1, At, B1); PG8_BAR; PG8_SCHED;
        }
        if (wr == 0) PG8_BAR;
        epilogue(P, acc, cur, wr, wc, fr, fq, lds);
        if (!has_next) break;
#pragma unroll
        for (int a = 0; a < 2; ++a)
#pragma unroll
            for (int b = 0; b < 2; ++b)
#pragma unroll
                for (int m = 0; m < 4; ++m)
#pragma unroll
                    for (int n = 0; n < 2; ++n) acc[a][b][m][n] = (f32x4){0.f, 0.f, 0.f, 0.f};
        cur = nxt; cA = nA; cB = nB; ++ui;
        if (wr == 1) PG8_BAR;
    }
    PG8_WAIT_V(0);
    PG8_BAR;
#undef PG8_SA
#undef PG8_SB
#undef PG8_STAGE
#undef PG8_LDA
#undef PG8_LDB
#undef PG8_MMA
#undef PG8_WAIT_V
#undef PG8_WAIT_L
#undef PG8_BAR
#undef PG8_SCHED
}
}

constexpr int P0_CHUNKS = 640;
template <bool PERMW> __device__ __forceinline__ void p0_transpose(const float* __restrict__ W, int ldw, int Kd, bf16_t* __restrict__ WT, int chunk0, int nchunks, int kshift, int tid, int bid, int G) {
    const int nn = tid & 63, k8 = tid >> 6;
#pragma unroll 4
    for (int it = chunk0 + bid; it < nchunks; it += G) {
        const int ntile = it >> kshift, kt = it & ((1 << kshift) - 1);
        const int np = ntile * 64 + nn;
        const int col = PERMW ? col_of(np) : np;
        const float* src = W + (size_t)(kt * 64 + k8 * 8) * ldw + col;
        float v[8];
#pragma unroll
        for (int e = 0; e < 8; ++e) v[e] = src[(size_t)e * ldw];
        u32x4 w; w.x = cvt_pk_bf16(v[0], v[1]); w.y = cvt_pk_bf16(v[2], v[3]); w.z = cvt_pk_bf16(v[4], v[5]); w.w = cvt_pk_bf16(v[6], v[7]);
        *(u32x4*)(WT + (size_t)np * Kd + kt * 64 + k8 * 8) = w;
    }
}

__device__ __forceinline__ void p0_prep(const Params& P, LAS unsigned char* lds) {
    const int tid = threadIdx.x, bid = blockIdx.x, G = gridDim.x;
    unsigned char* ws = P.ws;
    if (bid < 96) {
        LAS float* sc = (LAS float*)(lds + 32768);
        LAS float* red = (LAS float*)(lds + 65536);
        for (int i = tid; i < 8192; i += 512) sc[i] = siluf_(P.c[i]);
        __syncthreads();
        const int cl = tid & 31, kg = tid >> 5, col = bid * 32 + cl;
        float a[8];
#pragma unroll
        for (int b = 0; b < 8; ++b) a[b] = 0.f;
#pragma unroll
        for (int kb = 0; kb < 4; ++kb) {
            float w[16];
#pragma unroll
            for (int i = 0; i < 16; ++i) w[i] = P.w_ada[(size_t)(kg * 64 + kb * 16 + i) * 3072 + col];
#pragma unroll
            for (int i = 0; i < 16; ++i)
#pragma unroll
                for (int b = 0; b < 8; ++b) a[b] += sc[b * 1024 + kg * 64 + kb * 16 + i] * w[i];
        }
#pragma unroll
        for (int b = 0; b < 8; ++b) red[(kg * 8 + b) * 32 + cl] = a[b];
        __syncthreads();
        if (tid < 256) {
            const int b = tid >> 5; float s = 0.f;
#pragma unroll
            for (int g = 0; g < 16; ++g) s += red[(g * 8 + b) * 32 + cl];
            __hip_atomic_store((float*)(ws + WS_MOD) + b * 3072 + col, s + P.b_ada[col], __ATOMIC_RELAXED, __HIP_MEMORY_SCOPE_AGENT);
        }
        asm volatile("s_waitcnt vmcnt(0)" ::: "memory");
        __syncthreads();
        if (tid == 0) __hip_atomic_fetch_add((unsigned*)(ws + WS_CTL) + 192, 1u, __ATOMIC_RELAXED, __HIP_MEMORY_SCOPE_AGENT);
    }
    else if (G > 96) {
        p0_transpose<true>(P.w_in, 10240, 1024, (bf16_t*)(ws + WS_WIN), 0, P0_CHUNKS, 4, tid, bid - 96, G - 96);
    }
}
__device__ __forceinline__ void p0_rest(const Params& P) {
    const int tid = threadIdx.x, bid = blockIdx.x, G = gridDim.x;
    unsigned char* ws = P.ws;
    p0_transpose<true>(P.w_in, 10240, 1024, (bf16_t*)(ws + WS_WIN), (G > 96) ? P0_CHUNKS : 0, 2560, 4, tid, bid, G);
    p0_transpose<false>(P.w_conv_out, 1024, 1024, (bf16_t*)(ws + WS_WC), 0, 256, 4, tid, bid, G);
    p0_transpose<false>(P.w_attn_out, 1024, 512, (bf16_t*)(ws + WS_WA), 0, 128, 3, tid, bid, G);
    p0_transpose<false>(P.w_out, 1024, 1024, (bf16_t*)(ws + WS_WO), 0, 256, 4, tid, bid, G);
}

__device__ __forceinline__ f32x4 ld_agent4(const float* p) {
    const unsigned long long a = __hip_atomic_load((const unsigned long long*)p, __ATOMIC_RELAXED, __HIP_MEMORY_SCOPE_AGENT);
    const unsigned long long b = __hip_atomic_load((const unsigned long long*)(p + 2), __ATOMIC_RELAXED, __HIP_MEMORY_SCOPE_AGENT);
    return (f32x4){__builtin_bit_cast(float, (unsigned)a), __builtin_bit_cast(float, (unsigned)(a >> 32)), __builtin_bit_cast(float, (unsigned)b), __builtin_bit_cast(float, (unsigned)(b >> 32))};
}
__device__ __forceinline__ void p0b_h(const Params& P) {
    const int tid = threadIdx.x, lane = tid & 63, wid = tid >> 6;
    const float* mod = (const float*)(P.ws + WS_MOD);
    bf16_t* H = (bf16_t*)(P.ws + WS_H);
    if (threadIdx.x == 0) { while (__hip_atomic_load((unsigned*)(P.ws + WS_CTL) + 192, __ATOMIC_RELAXED, __HIP_MEMORY_SCOPE_AGENT) < 96u) __builtin_amdgcn_s_sleep(1); }
    __syncthreads();
    const int nw = gridDim.x * 8, gw = blockIdx.x * 8 + wid;
    const int rpw = T / nw;
    const int rbeg = gw * rpw, b = rbeg >> 12;
    f32x4 mul[4], add[4];
#pragma unroll
    for (int i = 0; i < 4; ++i) {
        const int idx = i * 256 + lane * 4;
        const f32x4 nwv = *(const f32x4*)(P.norm_w + idx), sh = ld_agent4(mod + b * 3072 + idx), sc = ld_agent4(mod + b * 3072 + 1024 + idx);
        mul[i] = nwv * (sc + 1.0f); add[i] = sh;
    }
    for (int r = rbeg; r < rbeg + rpw; r += 4) {
        f32x4 v[4][4]; float ss[4];
#pragma unroll
        for (int q = 0; q < 4; ++q)
#pragma unroll
            for (int i = 0; i < 4; ++i) v[q][i] = __builtin_nontemporal_load((const f32x4*)(P.x + (size_t)(r + q) * 1024 + i * 256 + lane * 4));
#pragma unroll
        for (int q = 0; q < 4; ++q) {
            float s = 0.f;
#pragma unroll
            for (int i = 0; i < 4; ++i) s += (v[q][i][0] * v[q][i][0] + v[q][i][1] * v[q][i][1]) + (v[q][i][2] * v[q][i][2] + v[q][i][3] * v[q][i][3]);
            ss[q] = wave_sum(s);
        }
#pragma unroll
        for (int q = 0; q < 4; ++q) {
            const float rs = __builtin_amdgcn_rsqf(ss[q] * (1.0f / 1024.0f) + EPS);
#pragma unroll
            for (int i = 0; i < 4; ++i) {
                const f32x4 h = (v[q][i] * rs) * mul[i] + add[i];
                u32x2 w; w.x = cvt_pk_bf16(h[0], h[1]); w.y = cvt_pk_bf16(h[2], h[3]);
                *(u32x2*)(H + (size_t)(r + q) * 1024 + i * 256 + lane * 4) = w;
            }
        }
    }
}

__device__ __forceinline__ void p2_conv(const Params& P, LAS unsigned char* lds) {
    int tid = threadIdx.x; asm volatile("" : "+v"(tid));
    const int lane = tid & 63, wid = tid >> 6, G = gridDim.x, bid = blockIdx.x;
    const bf16_t* U = (const bf16_t*)(P.ws + WS_U);
    const bf16_t* SGC = (const bf16_t*)(P.ws + WS_SGC);
    bf16_t* A2 = (bf16_t*)(P.ws + WS_A2);
    LAS float* st = (LAS float*)(lds + RING_BYTES);
    LAS float* tot = (LAS float*)(lds + RING_BYTES + 2048);
    const int ch = 2 * tid;
    f32x2 cw[31];
#pragma unroll
    for (int j = 0; j < 31; ++j) cw[j] = *(const f32x2*)(P.conv_w + j * 1024 + ch);
    const f32x2 cb = *(const f32x2*)(P.conv_b + ch), lw = *(const f32x2*)(P.ln_w + ch), lb = *(const f32x2*)(P.ln_b + ch);
    constexpr int NT = T / 16, NCH = 46 * 128;
    const int t0 = (int)((long)NT * bid / G), t1 = (int)((long)NT * (bid + 1) / G);
    u32x4 tv[6];
#define CONV_LOAD(TILE, HB) do { const int _r0 = (TILE) * 16, _s0 = _r0 & (SEQ - 1); _Pragma("unroll") for (int _it = 0; _it < 6; ++_it) { \
        int _i = tid + ((HB) * 6 + _it) * 512; if (_i > NCH - 1) _i = NCH - 1; const int _row = _i >> 7, _c16 = _i & 127; \
        int _sr = _r0 - 30 + _row; if (_s0 - 30 + _row < 0) _sr = _r0; tv[_it] = *(const u32x4*)(U + (size_t)_sr * 1024 + _c16 * 8); } } while (0)
#define CONV_WRITE(TILE, HB) do { const int _s0 = ((TILE) * 16) & (SEQ - 1); _Pragma("unroll") for (int _it = 0; _it < 6; ++_it) { \
        const int _i = tid + ((HB) * 6 + _it) * 512; const int _row = _i >> 7, _c16 = _i & 127; u32x4 _v = tv[_it]; \
        if (_s0 - 30 + _row < 0) _v = (u32x4){0u, 0u, 0u, 0u}; if (_i < NCH) *(LAS u32x4*)(lds + _row * 2048 + _c16 * 16) = _v; } } while (0)
    if (t0 < t1) { CONV_LOAD(t0, 0); CONV_WRITE(t0, 0); CONV_LOAD(t0, 1); CONV_WRITE(t0, 1); }
    for (int tile = t0; tile < t1; ++tile) {
        const bool has_next = tile + 1 < t1;
        __syncthreads();
#pragma unroll
        for (int g = 0; g < 2; ++g) {
            const int r0 = tile * 16 + g * 8;
            const bool pre = has_next && g == 1;
            f32x2 a[8];
            {
                f32x2 uin[38];
#pragma unroll
                for (int i = 0; i < 38; ++i) { const unsigned w = *(const LAS unsigned*)(lds + (g * 8 + i) * 2048 + tid * 4); uin[i] = (f32x2){bf_lo(w), bf_hi(w)}; }
#pragma unroll
                for (int r = 0; r < 8; ++r) {
                    f32x2 v = cb;
#pragma unroll
                    for (int j = 0; j < 31; ++j) v += cw[j] * uin[r + j];
                    a[r] = v;
                }
            }
            {
                float sv[16];
#pragma unroll
                for (int r = 0; r < 8; ++r) { sv[2 * r] = a[r][0] + a[r][1]; sv[2 * r + 1] = a[r][0] * a[r][0] + a[r][1] * a[r][1]; }
#define BFLY(HALF, BIT) do { const bool up = (lane & (BIT)) != 0; _Pragma("unroll") for (int i = 0; i < (HALF); ++i) { \
                const float keep = up ? sv[i + (HALF)] : sv[i], send = up ? sv[i] : sv[i + (HALF)]; sv[i] = keep + __shfl_xor(send, (BIT)); } } while (0)
#define BFLYP(HALF, BIT, XP) do { const bool up = (lane & (BIT)) != 0; _Pragma("unroll") for (int i = 0; i < (HALF); ++i) { \
                const float keep = up ? sv[i + (HALF)] : sv[i], send = up ? sv[i] : sv[i + (HALF)]; sv[i] = keep + XP(send, lane); } } while (0)
                BFLYP(8, 32, xpartner32); BFLYP(4, 16, xpartner16); BFLY(2, 8); BFLY(1, 4);
#undef BFLYP
#undef BFLY
                float v = sv[0]; v += __shfl_xor(v, 2); v += __shfl_xor(v, 1);
                if ((lane & 3) == 0) st[wid * 16 + (lane >> 2)] = v;
            }
            __syncthreads();
            if (pre) CONV_LOAD(tile + 1, 0);
            if (tid < 16) { float s = 0.f;
#pragma unroll
                for (int w = 0; w < 8; ++w) s += st[w * 16 + tid];
                tot[tid] = s; }
            unsigned gw[8];
#pragma unroll
            for (int r = 0; r < 8; ++r) gw[r] = *(const unsigned*)(SGC + (size_t)(r0 + r) * 1024 + ch);
            __syncthreads();
            if (pre) { CONV_WRITE(tile + 1, 0); CONV_LOAD(tile + 1, 1); }
#pragma unroll
            for (int r = 0; r < 8; ++r) {
                const f32x2 t2 = *(const LAS f32x2*)(tot + 2 * r);
                const float mu = t2[0] * (1.0f / 1024.0f), var = t2[1] * (1.0f / 1024.0f) - mu * mu;
                const float rstd = __builtin_amdgcn_rsqf(fmaxf(var, 0.f) + EPS);
                const float y0 = siluf_((a[r][0] - mu) * rstd * lw[0] + lb[0]) * bf_lo(gw[r]);
                const float y1 = siluf_((a[r][1] - mu) * rstd * lw[1] + lb[1]) * bf_hi(gw[r]);
                *(unsigned*)(A2 + (size_t)(r0 + r) * 1024 + ch) = cvt_pk_bf16(y0, y1);
            }
            if (pre) CONV_WRITE(tile + 1, 1);
        }
    }
#undef CONV_LOAD
#undef CONV_WRITE
}

__device__ __forceinline__ s16x4 vtr(LAS unsigned char* p) { return __builtin_bit_cast(s16x4, __builtin_amdgcn_ds_read_tr16_b64_v4i16((LAS s16x4*)p)); }

struct AItem { int g, d, b, head, r, n, chain; };
__device__ __forceinline__ AItem adecode(int I) {
    AItem it; it.g = I >> 10; const int rem = I & 1023, bh = rem >> 5, w = rem & 31;
    it.d = 1 << (2 * it.g); const int sh = 5 - 2 * it.g;
    it.r = w >> sh; it.n = w & ((1 << sh) - 1); it.b = bh >> 2; it.head = it.g * 4 + (bh & 3); it.chain = I >> sh; return it;
}

__device__ __forceinline__ void attn_compute(LAS unsigned char* lds, const int par, const AItem& cur, const bf16x8 (&qf)[4], bf16_t* Op, float* LSE, const int wid, const int c, const int fq) {
        f32x4 sacc[9];
#pragma unroll
        for (int tau = 0; tau < 9; ++tau) {
            const int kt = wid + tau;
            const unsigned kb = (unsigned)((((kt >> 3) ^ par) * 32768) + ((kt & 7) * 16 + c) * 256);
            f32x4 a = (f32x4){0.f, 0.f, 0.f, 0.f};
#pragma unroll
            for (int s = 0; s < 4; ++s) {
                const bf16x8 kf = *(const LAS bf16x8*)(lds + kb + ((((4 * s + fq) ^ c)) << 4));
                a = __builtin_amdgcn_mfma_f32_16x16x32_bf16(kf, qf[s], a, 0, 0, 0);
            }
            sacc[tau] = a;
        }
        float mx = -INFINITY;
#pragma unroll
        for (int tau = 0; tau < 9; ++tau)
#pragma unroll
            for (int jj = 0; jj < 4; ++jj) {
                const int rel = 16 * tau + 4 * fq + jj - c;
                const bool valid = (rel >= 0) && (rel <= 128) && ((cur.n > 0) || (wid + tau >= 8));
                const float s = valid ? sacc[tau][jj] : -INFINITY;
                sacc[tau][jj] = s; mx = fmaxf(mx, s);
            }
        mx = fmaxf(mx, __shfl_xor(mx, 16)); mx = fmaxf(mx, __shfl_xor(mx, 32));
        float lsum = 0.f;
#pragma unroll
        for (int tau = 0; tau < 9; ++tau)
#pragma unroll
            for (int jj = 0; jj < 4; ++jj) { const float p = fast_exp2(sacc[tau][jj] - mx); sacc[tau][jj] = p; lsum += p; }
        lsum += __shfl_xor(lsum, 16); lsum += __shfl_xor(lsum, 32);
        bf16x8 pb[5];
#pragma unroll
        for (int s5 = 0; s5 < 5; ++s5) {
            const f32x4 pa = sacc[2 * s5];
            f32x4 pc = (f32x4){0.f, 0.f, 0.f, 0.f};
            if (s5 < 4) pc = sacc[2 * s5 + 1];
            u32x4 w; w.x = cvt_pk_bf16(pa[0], pa[1]); w.y = cvt_pk_bf16(pa[2], pa[3]); w.z = cvt_pk_bf16(pc[0], pc[1]); w.w = cvt_pk_bf16(pc[2], pc[3]);
            pb[s5] = __builtin_bit_cast(bf16x8, w);
        }
        f32x4 oacc[8];
#pragma unroll
        for (int mt = 0; mt < 8; ++mt) oacc[mt] = (f32x4){0.f, 0.f, 0.f, 0.f};
        const int q4 = c >> 2, p4 = c & 3;
        const int krow = 4 * fq + q4, k7 = krow & 7;
#pragma unroll
        for (int s5 = 0; s5 < 5; ++s5) {
            const int kta = wid + 2 * s5; int ktb = wid + 2 * s5 + 1; if (ktb > 15) ktb = 15;
            LAS unsigned char* ba = lds + 65536 + ((((kta >> 3) ^ par) * 32768) + ((kta & 7) * 16 + krow) * 256 + 8 * (p4 & 1));
            LAS unsigned char* bb = lds + 65536 + ((((ktb >> 3) ^ par) * 32768) + ((ktb & 7) * 16 + krow) * 256 + 8 * (p4 & 1));
#pragma unroll
            for (int mt = 0; mt < 8; ++mt) {
                const int chs = ((2 * mt + (p4 >> 1)) ^ (k7 << 1)) << 4;
                const s16x4 va = vtr(ba + chs), vb = vtr(bb + chs);
                const bf16x8 af = (bf16x8){va[0], va[1], va[2], va[3], vb[0], vb[1], vb[2], vb[3]};
                oacc[mt] = __builtin_amdgcn_mfma_f32_16x16x32_bf16(af, pb[s5], oacc[mt], 0, 0, 0);
            }
        }
        {
            const float inv = fast_rcp(lsum);
            const size_t tq = (size_t)cur.b * SEQ + (size_t)(cur.n * 128 + wid * 16 + c) * cur.d + cur.r;
            bf16_t* orow = Op + ((size_t)(cur.b * 12 + cur.head) * SEQ + (size_t)cur.r * (SEQ / cur.d) + cur.n * 128 + wid * 16 + c) * 128 + 4 * fq;
#pragma unroll
            for (int mt = 0; mt < 8; ++mt) {
                u32x2 w; w.x = cvt_pk_bf16(oacc[mt][0] * inv, oacc[mt][1] * inv); w.y = cvt_pk_bf16(oacc[mt][2] * inv, oacc[mt][3] * inv);
                *(u32x2*)(orow + mt * 16) = w;
            }
            if (fq == 0) LSE[tq * 12 + cur.head] = mx + __builtin_amdgcn_logf(lsum);
        }
}

__device__ __forceinline__ void p4_attn(const Params& P, LAS unsigned char* lds) {
    int tid = threadIdx.x; asm volatile("" : "+v"(tid));
    const int lane = tid & 63, wid = __builtin_amdgcn_readfirstlane(tid >> 6), c = lane & 15, fq = lane >> 4;
    const bf16_t* Qp = (const bf16_t*)(P.ws + WS_Q); const bf16_t* Kp = (const bf16_t*)P.out; const bf16_t* Vp = (const bf16_t*)(P.ws + WS_V);
    bf16_t* Op = (bf16_t*)(P.ws + WS_Q); float* LSE = (float*)(P.ws + WS_LSE);
    const int G = gridDim.x, bid = blockIdx.x;
    const int i0 = (int)((long)3072 * bid / G), i1 = (int)((long)3072 * (bid + 1) / G);
    if (i0 >= i1) return;
    const int srow = tid >> 4, sch = tid & 15;
    u32x4 k0[4], v0[4], k1[4], v1[4]; bf16x8 qf[4], q0[4], q1[4];
#define LOAD_BLOCK(KR, VR, IT, NBLK) do { _Pragma("unroll") for (int _i = 0; _i < 4; ++_i) { const int _row = srow + 32 * _i; \
        const size_t _o = ((size_t)((IT).b * 12 + (IT).head) * SEQ + (size_t)(IT).r * (SEQ / (IT).d) + (NBLK) * 128 + _row) * 128 + sch * 8; \
        KR[_i] = *(const u32x4*)(Kp + _o); VR[_i] = *(const u32x4*)(Vp + _o); } } while (0)
#define ZERO_BLOCK(KR, VR) do { _Pragma("unroll") for (int _i = 0; _i < 4; ++_i) { KR[_i] = (u32x4){0u, 0u, 0u, 0u}; VR[_i] = (u32x4){0u, 0u, 0u, 0u}; } } while (0)
#define WRITE_BLOCK(KR, VR, SLOT) do { _Pragma("unroll") for (int _i = 0; _i < 4; ++_i) { const int _row = srow + 32 * _i; \
        *(LAS u32x4*)(lds + (SLOT) * 32768 + _row * 256 + ((sch ^ (_row & 15)) << 4)) = KR[_i]; \
        *(LAS u32x4*)(lds + 65536 + (SLOT) * 32768 + _row * 256 + ((sch ^ ((_row & 7) << 1)) << 4)) = VR[_i]; } } while (0)
#define LOAD_Q(DST, IT) do { const size_t _o = ((size_t)((IT).b * 12 + (IT).head) * SEQ + (size_t)(IT).r * (SEQ / (IT).d) + (IT).n * 128 + wid * 16 + c) * 128; \
        _Pragma("unroll") for (int _s = 0; _s < 4; ++_s) DST[_s] = *(const bf16x8*)(Qp + _o + _s * 32 + fq * 8); } while (0)
#define ATTN_ITEM(KL, VL, QL, KW, VW, QW) do { \
        if (I + 2 < i1) { const AItem n2 = adecode(I + 2); LOAD_BLOCK(KL, VL, n2, n2.n); LOAD_Q(QL, n2); } \
        attn_compute(lds, par, cur, qf, Op, LSE, wid, c, fq); \
        __syncthreads();                                             \
        if (I + 1 < i1) { const AItem nx = adecode(I + 1); \
            if (nx.chain == cur.chain) { WRITE_BLOCK(KW, VW, par); par ^= 1; }                \
            else { WRITE_BLOCK(KW, VW, par ^ 1); ZERO_BLOCK(KW, VW); WRITE_BLOCK(KW, VW, par); }     \
            _Pragma("unroll") for (int _s = 0; _s < 4; ++_s) qf[_s] = QW[_s]; \
            cur = nx; } \
        __syncthreads(); } while (0)

    AItem cur = adecode(i0);
    int par = 0;
    if (cur.n > 0) LOAD_BLOCK(k0, v0, cur, cur.n - 1); else ZERO_BLOCK(k0, v0);
    WRITE_BLOCK(k0, v0, 0);
    LOAD_BLOCK(k0, v0, cur, cur.n);
    WRITE_BLOCK(k0, v0, 1);
    LOAD_Q(qf, cur);
    if (i0 + 1 < i1) { const AItem n1 = adecode(i0 + 1); LOAD_BLOCK(k1, v1, n1, n1.n); LOAD_Q(q1, n1); }
    __syncthreads();
    for (int I = i0; I < i1; I += 2) {
        ATTN_ITEM(k0, v0, q0, k1, v1, q1);
        if (I + 1 < i1) { ++I; ATTN_ITEM(k1, v1, q1, k0, v0, q0); --I; }
    }
#undef ATTN_ITEM
#undef LOAD_BLOCK
#undef ZERO_BLOCK
#undef WRITE_BLOCK
#undef LOAD_Q
}

__device__ __forceinline__ void p5_combine(const Params& P) {
    const bf16_t* Op = (const bf16_t*)(P.ws + WS_Q); const float* LSE = (const float*)(P.ws + WS_LSE); bf16_t* SGA = (bf16_t*)(P.ws + WS_SGA);
    const long total = (long)T * 64;
#pragma unroll 4
    for (long i = (long)blockIdx.x * 512 + threadIdx.x; i < total; i += (long)gridDim.x * 512) {
        const long row = i >> 6; const int c8 = (int)(i & 63), hh = c8 >> 4, d8 = (c8 & 15) * 8;
        const float l0 = LSE[row * 12 + hh], l1 = LSE[row * 12 + 4 + hh], l2 = LSE[row * 12 + 8 + hh];
        const float M = fmaxf(l0, fmaxf(l1, l2));
        float w0 = fast_exp2(l0 - M), w1 = fast_exp2(l1 - M), w2 = fast_exp2(l2 - M);
        const float inv = fast_rcp(w0 + w1 + w2); w0 *= inv; w1 *= inv; w2 *= inv;
        const int bb = (int)(row >> 12), ss = (int)(row & (SEQ - 1));
        const u32x4 a = *(const u32x4*)(Op + qkv_off(bb, hh, ss) + d8), b = *(const u32x4*)(Op + qkv_off(bb, 4 + hh, ss) + d8), cc = *(const u32x4*)(Op + qkv_off(bb, 8 + hh, ss) + d8);
        const u32x4 g = *(const u32x4*)(SGA + row * 512 + hh * 128 + d8);
        u32x4 o;
#define CMB(F) { const float lo = (w0 * bf_lo(a.F) + w1 * bf_lo(b.F) + w2 * bf_lo(cc.F)) * bf_lo(g.F); const float hi = (w0 * bf_hi(a.F) + w1 * bf_hi(b.F) + w2 * bf_hi(cc.F)) * bf_hi(g.F); o.F = cvt_pk_bf16(lo, hi); }
        CMB(x) CMB(y) CMB(z) CMB(w)
#undef CMB
        *(u32x4*)(SGA + row * 512 + hh * 128 + d8) = o;
    }
}

extern __shared__ __attribute__((aligned(16))) unsigned char dyn_lds[];

__device__ __forceinline__ unsigned xcc_id() { return (unsigned)__builtin_amdgcn_s_getreg((3 << 11) | 20) & 0xFu; }
__device__ __forceinline__ void grid_seam(unsigned char* ws, LAS unsigned* sw  , const unsigned gen  , const unsigned G) {
    asm volatile("s_waitcnt vmcnt(0) lgkmcnt(0)" ::: "memory");
    __syncthreads();
    if (threadIdx.x == 0) {
        unsigned* ctl = (unsigned*)(ws + WS_CTL);
        unsigned* top = ctl + 64; unsigned* regtot = ctl + 128;
        const unsigned xcc = sw[2];
        const unsigned old = __hip_atomic_fetch_add(ctl + 256 + xcc * 64, 1u, __ATOMIC_RELAXED, __HIP_MEMORY_SCOPE_AGENT);
        unsigned nmine, nxcd;
        if (gen == 1u) {
            while (__hip_atomic_load(regtot, __ATOMIC_RELAXED, __HIP_MEMORY_SCOPE_AGENT) < G) __builtin_amdgcn_s_sleep(1);
            nmine = 0u; nxcd = 0u;
#pragma unroll
            for (int j = 0; j < 16; ++j) { const unsigned c = __hip_atomic_load(ctl + 2048 + j * 64, __ATOMIC_RELAXED, __HIP_MEMORY_SCOPE_AGENT); nxcd += (c != 0u); if ((unsigned)j == xcc) nmine = c; }
            sw[0] = nmine; sw[1] = nxcd;
        } else { nmine = sw[0]; nxcd = sw[1]; }
        if (old == nmine * gen - 1u) {
            __builtin_amdgcn_fence(__ATOMIC_RELEASE, "agent");
            asm volatile("s_waitcnt vmcnt(0)" ::: "memory");
            __hip_atomic_fetch_add(top, 1u, __ATOMIC_RELAXED, __HIP_MEMORY_SCOPE_AGENT);
        }
        const unsigned target = nxcd * gen;
        while (__hip_atomic_load(top, __ATOMIC_RELAXED, __HIP_MEMORY_SCOPE_AGENT) < target) __builtin_amdgcn_s_sleep(1);
        __builtin_amdgcn_fence(__ATOMIC_ACQUIRE, "agent");
        asm volatile("s_waitcnt vmcnt(0)" ::: "memory");
    }
    __syncthreads();
}
#define GSYNC_CG() do { asm volatile("s_waitcnt vmcnt(0) lgkmcnt(0)" ::: "memory"); __syncthreads(); \
    if (threadIdx.x < 64) { __builtin_amdgcn_fence(__ATOMIC_RELEASE, "agent"); asm volatile("s_waitcnt vmcnt(0)" ::: "memory"); } \
    grid.sync(); \
    if (threadIdx.x < 64) { __builtin_amdgcn_fence(__ATOMIC_ACQUIRE, "agent"); asm volatile("s_waitcnt vmcnt(0)" ::: "memory"); } __syncthreads(); } while (0)
#define GSYNC(GEN) grid_seam(P.ws, (LAS unsigned*)(lds + RING_BYTES + 12288), (GEN), (unsigned)G)

__global__ void __launch_bounds__(512, 2) fwd_megakernel(Params P) {
    cg::grid_group grid = cg::this_grid();
    LAS unsigned char* lds = (LAS unsigned char*)dyn_lds;
    unsigned char* ws = P.ws;
    const int G = gridDim.x, bid = blockIdx.x;

    if (threadIdx.x == 0) {
        const unsigned myxcc = xcc_id();
        ((LAS unsigned*)(lds + RING_BYTES + 12288))[2] = myxcc;
        __hip_atomic_fetch_add((unsigned*)(ws + WS_CTL) + 2048 + myxcc * 64, 1u, __ATOMIC_RELAXED, __HIP_MEMORY_SCOPE_AGENT);
        asm volatile("s_waitcnt vmcnt(0)" ::: "memory");
        __hip_atomic_fetch_add((unsigned*)(ws + WS_CTL) + 128, 1u, __ATOMIC_RELAXED, __HIP_MEMORY_SCOPE_AGENT);
    }
    if (P.ws == nullptr) grid.sync();
    p0_prep(P, lds);
    p0b_h(P);
    p0_rest(P);
    GSYNC(1u);
    { pg8::Sched2 S; S.mode = 0; S.G = G; S.c = bid; pg8::gemm_phase(P, lds, 1024, S); }
    GSYNC(2u);
    p2_conv(P, lds);
    GSYNC(3u);
    { pg8::Sched2 S; S.mode = 1; S.G = G; S.c = bid; pg8::gemm_phase(P, lds, 1024, S); }
    GSYNC(4u);
    p4_attn(P, lds);
    GSYNC(5u);
    p5_combine(P);
    GSYNC(6u);
    { pg8::Sched2 S; S.mode = 2; S.G = G; S.c = bid; pg8::gemm_phase(P, lds, 512, S); }
    GSYNC(7u);
    { pg8::Sched2 S; S.mode = 3; S.G = G; S.c = bid; pg8::gemm_phase(P, lds, 1024, S); }
}

extern "C" void kernel_launch(void* const* d_in, const int* in_sizes, int n_in, void* d_out, int out_size, void* d_ws, size_t ws_size, hipStream_t stream) {
    static int grid = 0;
    if (grid == 0) {
        if (n_in != 16 || out_size != T * DM || ws_size < WS_END) { fprintf(stderr, "kernel_launch: unexpected shapes (n_in %d out %d ws %zu)\n", n_in, out_size, ws_size); grid = -1; return; }
        int dev = 0, cus = 0, per_cu = 0;
        if (hipGetDevice(&dev) != hipSuccess || hipDeviceGetAttribute(&cus, hipDeviceAttributeMultiprocessorCount, dev) != hipSuccess) { grid = -1; return; }
        if (hipFuncSetAttribute((const void*)fwd_megakernel, hipFuncAttributeMaxDynamicSharedMemorySize, LDS_BYTES) != hipSuccess) { fprintf(stderr, "kernel_launch: hipFuncSetAttribute failed\n"); grid = -1; return; }
        if (hipOccupancyMaxActiveBlocksPerMultiprocessor(&per_cu, (const void*)fwd_megakernel, 512, LDS_BYTES) != hipSuccess || per_cu < 1) { fprintf(stderr, "kernel_launch: occupancy query says %d\n", per_cu); (void)hipGetLastError(); }
        grid = cus;
    }
    if (grid < 0) return;
    Params p{};
    p.x = (const float*)d_in[0]; p.c = (const float*)d_in[1]; p.pos = (const int*)d_in[2]; p.norm_w = (const float*)d_in[3]; p.w_ada = (const float*)d_in[4]; p.b_ada = (const float*)d_in[5];
    p.w_in = (const float*)d_in[6]; p.conv_w = (const float*)d_in[7]; p.conv_b = (const float*)d_in[8]; p.ln_w = (const float*)d_in[9]; p.ln_b = (const float*)d_in[10]; p.w_conv_out = (const float*)d_in[11];
    p.qn_w = (const float*)d_in[12]; p.kn_w = (const float*)d_in[13]; p.w_attn_out = (const float*)d_in[14]; p.w_out = (const float*)d_in[15];
    p.out = (float*)d_out; p.ws = (unsigned char*)d_ws;
    if (hipMemsetAsync((unsigned char*)d_ws + WS_CTL, 0, CTL_BYTES, stream) != hipSuccess) { fprintf(stderr, "kernel_launch: memset failed\n"); return; }
    void* args[] = {&p};
    hipError_t e = hipLaunchCooperativeKernel((const void*)fwd_megakernel, dim3(grid), dim3(512), args, LDS_BYTES, stream);
    if (e != hipSuccess) fprintf(stderr, "kernel_launch: cooperative launch failed: %s (grid %d)\n", hipGetErrorString(e), grid);
}
```

```cpp
#include <hip/hip_runtime.h>
#include <hip/hip_cooperative_groups.h>
#include <cstdio>
#include <cstdint>
namespace cg = cooperative_groups;

#define LAS __attribute__((address_space(3)))
typedef unsigned short bf16_t;
typedef short bf16x8 __attribute__((ext_vector_type(8)));
typedef short s16x4 __attribute__((ext_vector_type(4)));
typedef float f32x4 __attribute__((ext_vector_type(4)));
typedef float f32x2 __attribute__((ext_vector_type(2)));
typedef unsigned u32x4 __attribute__((ext_vector_type(4)));
typedef unsigned u32x2 __attribute__((ext_vector_type(2)));

constexpr int T = 32768, DM = 1024, SEQ = 4096, NB = 8;
constexpr int QKVW = 1536;
constexpr float EPS = 1e-6f;
constexpr float LOG2E = 1.4426950408889634f;
constexpr float QSCALE = 0.08838834764831845f * 1.4426950408889634f;

constexpr size_t MiB = 1u << 20;
constexpr size_t WS_MOD = 0;
constexpr size_t WS_CTL = 768 * 1024;
constexpr size_t CTL_BYTES = 32 * 1024;
constexpr size_t WS_LSE = 1 * MiB;
constexpr size_t WS_WIN = 4 * MiB;
constexpr size_t WS_WC = 24 * MiB;
constexpr size_t WS_WA = 26 * MiB;
constexpr size_t WS_WO = 28 * MiB;
constexpr size_t WS_H = 32 * MiB;
constexpr size_t WS_A2 = 96 * MiB;
constexpr size_t WS_SMC = 160 * MiB;
constexpr size_t WS_U = 224 * MiB;
constexpr size_t WS_Q = 224 * MiB;
constexpr size_t WS_SGC = 288 * MiB;
constexpr size_t WS_SGA = 320 * MiB;
constexpr size_t WS_V = 352 * MiB;
constexpr size_t WS_SMA = 448 * MiB;
constexpr size_t WS_END = 512 * MiB;

constexpr int LDS_BYTES = 147456;
constexpr int RING_BYTES = 131072;

struct Params {
    const float *x, *c; const int* pos; const float *norm_w, *w_ada, *b_ada, *w_in, *conv_w, *conv_b, *ln_w, *ln_b, *w_conv_out, *qn_w, *kn_w, *w_attn_out, *w_out;
    float* out; unsigned char* ws;
};

typedef __bf16 bf16x2_t __attribute__((ext_vector_type(2)));
__device__ __forceinline__ unsigned cvt_pk_bf16(float lo, float hi) { f32x2 v = {lo, hi}; bf16x2_t b = __builtin_convertvector(v, bf16x2_t); return __builtin_bit_cast(unsigned, b); }
__device__ __forceinline__ float bf_lo(unsigned w) { return __builtin_bit_cast(float, w << 16); }
__device__ __forceinline__ float bf_hi(unsigned w) { return __builtin_bit_cast(float, w & 0xffff0000u); }
__device__ __forceinline__ float fast_exp2(float x) { return __builtin_amdgcn_exp2f(x); }
__device__ __forceinline__ float fast_rcp(float x) { return __builtin_amdgcn_rcpf(x); }
__device__ __forceinline__ float sigmoidf_(float x) { return fast_rcp(1.0f + fast_exp2(-x * LOG2E)); }
__device__ __forceinline__ float siluf_(float x) { return x * sigmoidf_(x); }
__device__ __forceinline__ unsigned opaque_copy(unsigned a) { unsigned b = a; asm volatile("" : "+v"(b)); return b; }
__device__ __forceinline__ float xpartner32(float v, int lane) { const unsigned a = __builtin_bit_cast(unsigned, v); const auto r = __builtin_amdgcn_permlane32_swap(a, opaque_copy(a), false, false); return __builtin_bit_cast(float, (lane & 32) ? r[0] : r[1]); }
__device__ __forceinline__ float xpartner16(float v, int lane) { const unsigned a = __builtin_bit_cast(unsigned, v); const auto r = __builtin_amdgcn_permlane16_swap(a, opaque_copy(a), false, false); return __builtin_bit_cast(float, (lane & 16) ? r[0] : r[1]); }
__device__ __forceinline__ float wave_sum(float v) {
    v += __shfl_xor(v, 32); v += __shfl_xor(v, 16); v += __shfl_xor(v, 8); v += __shfl_xor(v, 4); v += __shfl_xor(v, 2); v += __shfl_xor(v, 1); return v;
}

__device__ __forceinline__ size_t qkv_off(int b, int head, int s) {
    const int sh = 2 * (head >> 2);
    const int pos = ((s & ((1 << sh) - 1)) << (12 - sh)) | (s >> sh);
    return ((size_t)(b * 12 + head) * SEQ + pos) * 128;
}

__device__ __forceinline__ int col_of(int np) {
    if (np < 4096) {
        const int tile = np >> 8, p = np & 255;
        if (tile < 8) return (p < 128) ? (128 * tile + p) : (1024 + 128 * tile + (p - 128));
        if (tile < 12) return 2048 + 256 * (tile - 8) + p;
        return 8192 + 256 * (tile - 12) + p;
    }
    const int n2 = np - 4096, tile = n2 >> 8, p = n2 & 255;
    if (tile < 12) {
        const int head = 2 * (tile % 6) + (p >> 7), pp = p & 127;
        const int wc = pp >> 5, fq = (pp >> 3) & 3, n = (pp >> 2) & 1, j = pp & 3;
        const int d = 64 * n + 16 * wc + 4 * fq + j;
        return 3072 + (tile < 6 ? 0 : 1536) + head * 128 + d;
    }
    if (tile < 18) return 6144 + 256 * (tile - 12) + p;
    if (tile < 20) return 7680 + 256 * (tile - 18) + p;
    return 9216 + 256 * (tile - 20) + p;
}

namespace pg8 {
constexpr int BM = 256, BK = 64, HALF = 128, HTB = HALF * BK * 2, NXCD = 8, WGM = 8;
__device__ __forceinline__ int lds_byte(int r, int c) { const int st = (r >> 4) * 2 + (c >> 5), rr = r & 15, cc = c & 31, ob = rr * 64 + cc * 2; return st * 1024 + (ob ^ (((ob >> 9) & 1) << 5)); }
__device__ __forceinline__ void stage_rc(int b, int& R, int& C) { const int st = b / 1024, sb = b % 1024, swz = sb ^ (((sb >> 9) & 1) << 5); R = (st >> 1) * 16 + swz / 64; C = (st & 1) * 32 + (swz % 64) / 2; }
__device__ __forceinline__ int perm32(int rho) { const int n = rho >> 4, i = rho & 15; return 8 * (i >> 2) + 4 * n + (i & 3); }

struct Unit { int pm, pn, id; };
__device__ __forceinline__ size_t a_off(int id) { return id == 2 ? WS_A2 : (id == 3 ? WS_SGA : (id == 4 ? WS_SMC : WS_H)); }
__device__ __forceinline__ size_t b_off(int id) { return id == 0 ? WS_WIN : (id == 1 ? WS_WIN + (size_t)4096 * 1024 * 2 : (id == 2 ? WS_WC : (id == 3 ? WS_WA : WS_WO))); }
struct Sched2 {
    int mode, G, c;
    __device__ __forceinline__ bool next(int i, Unit& u) const {
        const int n0 = (mode == 0) ? 128 * 16 : 128 * 4, n1 = (mode == 1) ? 128 * 24 : 0;
        const long L = (long)i * G + c; if (L >= (long)(n0 + n1)) return false;
        const bool first = L < n0;
        const int nN = first ? ((mode == 0) ? 16 : 4) : 24;
        const int id = first ? ((mode == 0) ? 0 : (mode == 1 ? 2 : (mode == 2 ? 3 : 4))) : 1;
        int wgid = first ? (int)L : (int)L - n0; const int nwg = first ? n0 : n1;
        { const int q = nwg / NXCD, xcd = wgid % NXCD, off = wgid / NXCD; wgid = xcd * q + off; }
        const int nig = WGM * nN, gid = wgid / nig, fm = gid * WGM;
        u.pm = fm + ((wgid % nig) % WGM); u.pn = (wgid % nig) / WGM; u.id = id; return true;
    }
};
}

template <int ACT> __device__ __forceinline__ void epi_store_act(const f32x4 (&acc)[2][2][4][2], bf16_t* dst  , int ldc) {
#pragma unroll
    for (int ai = 0; ai < 2; ++ai)
#pragma unroll
        for (int m = 0; m < 4; ++m) {
            bf16_t* rowp = dst + (size_t)(ai * 128 + m * 16) * ldc;
#pragma unroll
            for (int bj = 0; bj < 2; ++bj) {
                f32x4 v0 = acc[ai][bj][m][0], v1 = acc[ai][bj][m][1];
                if (ACT == 1) { for (int j = 0; j < 4; ++j) { v0[j] = siluf_(v0[j]); v1[j] = siluf_(v1[j]); } }
                if (ACT == 2) { for (int j = 0; j < 4; ++j) { v0[j] = sigmoidf_(v0[j]); v1[j] = sigmoidf_(v1[j]); } }
                u32x4 w; w.x = cvt_pk_bf16(v0[0], v0[1]); w.y = cvt_pk_bf16(v0[2], v0[3]); w.z = cvt_pk_bf16(v1[0], v1[1]); w.w = cvt_pk_bf16(v1[2], v1[3]);
                *(u32x4*)(rowp + bj * 128) = w;
            }
        }
}

__device__ __forceinline__ void epilogue(const Params& P, const f32x4 (&acc)[2][2][4][2], const pg8::Unit& u, int wr, int wc, int fr, int fq, LAS unsigned char* lds) {
    const int row0 = u.pm * 256 + wr * 64 + fr;
    const int cw = wc * 32 + 8 * fq;
    unsigned char* ws = P.ws;
    if (u.id == 0) {
        if (u.pn < 8) {
            bf16_t* dst = (bf16_t*)(ws + WS_U) + (size_t)row0 * 1024 + u.pn * 128 + cw;
#pragma unroll
            for (int ai = 0; ai < 2; ++ai)
#pragma unroll
                for (int m = 0; m < 4; ++m) {
                    f32x4 a0 = acc[ai][0][m][0], a1 = acc[ai][0][m][1], b0 = acc[ai][1][m][0], b1 = acc[ai][1][m][1];
#pragma unroll
                    for (int j = 0; j < 4; ++j) { a0[j] *= sigmoidf_(b0[j]); a1[j] *= sigmoidf_(b1[j]); }
                    u32x4 w; w.x = cvt_pk_bf16(a0[0], a0[1]); w.y = cvt_pk_bf16(a0[2], a0[3]); w.z = cvt_pk_bf16(a1[0], a1[1]); w.w = cvt_pk_bf16(a1[2], a1[3]);
                    *(u32x4*)(dst + (size_t)(ai * 128 + m * 16) * 1024) = w;
                }
        } else if (u.pn < 12) {
            epi_store_act<1>(acc, (bf16_t*)(ws + WS_SGC) + (size_t)row0 * 1024 + (u.pn - 8) * 256 + cw, 1024);
        } else {
            epi_store_act<2>(acc, (bf16_t*)(ws + WS_SMC) + (size_t)row0 * 1024 + (u.pn - 12) * 256 + cw, 1024);
        }
    } else if (u.id == 1) {
        if (u.pn < 12) {
            const bool isq = u.pn < 6;
            LAS float* red = (LAS float*)(lds + RING_BYTES);
            float ss[2][2][4];
#pragma unroll
            for (int ai = 0; ai < 2; ++ai)
#pragma unroll
                for (int bj = 0; bj < 2; ++bj)
#pragma unroll
                    for (int m = 0; m < 4; ++m) {
                        const f32x4 a = acc[ai][bj][m][0], b = acc[ai][bj][m][1];
                        float s = (a[0] * a[0] + a[1] * a[1]) + (a[2] * a[2] + a[3] * a[3]) + (b[0] * b[0] + b[1] * b[1]) + (b[2] * b[2] + b[3] * b[3]);
                        s += xpartner16(s, fq << 4); s += xpartner32(s, fq << 4);
                        ss[ai][bj][m] = s;
                        if (fq == 0) red[(ai * 128 + wr * 64 + m * 16 + fr) * 8 + bj * 4 + wc] = s;
                    }
            asm volatile("s_waitcnt lgkmcnt(0)" ::: "memory");
            __builtin_amdgcn_s_barrier();
            asm volatile("" ::: "memory");
            const float* nw = isq ? P.qn_w : P.kn_w;
            const int d0 = 16 * wc + 4 * fq;
            const f32x4 w1 = *(const f32x4*)(nw + d0), w2 = *(const f32x4*)(nw + d0 + 64);
            float invf[4];
#pragma unroll
            for (int j = 0; j < 4; ++j) invf[j] = fast_exp2(-(float)(d0 + j) * (13.287712379549449f / 64.0f));
            const float osc = isq ? QSCALE : 1.0f;
            const int head0 = 2 * (u.pn % 6);
            bf16_t* dstb = isq ? (bf16_t*)(ws + WS_Q) : (bf16_t*)P.out;
#pragma unroll
            for (int ai = 0; ai < 2; ++ai)
#pragma unroll
                for (int m = 0; m < 4; ++m) {
                    const int row = row0 + ai * 128 + m * 16;
                    const float pos = (float)P.pos[row];
                    float cs[4], sn[4];
#pragma unroll
                    for (int j = 0; j < 4; ++j) {
                        const float ang = pos * invf[j];
                        const float k = rintf(ang * 0.15915494309189535f);
                        float r = fmaf(-k, 6.2831854820251465f, ang); r = fmaf(-k, -1.7484555e-7f, r);
                        const float rev = r * 0.15915494309189535f;
                        cs[j] = __builtin_amdgcn_cosf(rev); sn[j] = __builtin_amdgcn_sinf(rev);
                    }
#pragma unroll
                    for (int bj = 0; bj < 2; ++bj) {
                        const f32x4 t4 = *(const LAS f32x4*)(red + (ai * 128 + wr * 64 + m * 16 + fr) * 8 + bj * 4);
                        const float tot = (t4[0] + t4[1]) + (t4[2] + t4[3]);
                        const float rs = __builtin_amdgcn_rsqf(tot * (1.0f / 128.0f) + EPS) ;
                        f32x4 o1, o2;
#pragma unroll
                        for (int j = 0; j < 4; ++j) {
                            const float x1 = acc[ai][bj][m][0][j] * rs * w1[j], x2 = acc[ai][bj][m][1][j] * rs * w2[j];
                            o1[j] = (x1 * cs[j] - x2 * sn[j]) * osc; o2[j] = (x2 * cs[j] + x1 * sn[j]) * osc;
                        }
                        u32x4 w; w.x = cvt_pk_bf16(o1[0], o1[1]); w.y = cvt_pk_bf16(o1[2], o1[3]); w.z = cvt_pk_bf16(o2[0], o2[1]); w.w = cvt_pk_bf16(o2[2], o2[3]);
                        *(u32x4*)(dstb + qkv_off(row >> 12, head0 + bj, row & (SEQ - 1)) + cw) = w;
                    }
                }
            (void)ss;
        } else if (u.pn < 18) {
            bf16_t* vb = (bf16_t*)(ws + WS_V);
#pragma unroll
            for (int ai = 0; ai < 2; ++ai)
#pragma unroll
                for (int m = 0; m < 4; ++m) {
                    const int row = row0 + ai * 128 + m * 16;
#pragma unroll
                    for (int bj = 0; bj < 2; ++bj) {
                        const f32x4 v0 = acc[ai][bj][m][0], v1 = acc[ai][bj][m][1];
                        u32x4 w; w.x = cvt_pk_bf16(v0[0], v0[1]); w.y = cvt_pk_bf16(v0[2], v0[3]); w.z = cvt_pk_bf16(v1[0], v1[1]); w.w = cvt_pk_bf16(v1[2], v1[3]);
                        *(u32x4*)(vb + qkv_off(row >> 12, 2 * (u.pn - 12) + bj, row & (SEQ - 1)) + cw) = w;
                    }
                }
        } else if (u.pn < 20) {
            epi_store_act<1>(acc, (bf16_t*)(ws + WS_SGA) + (size_t)row0 * 512 + (u.pn - 18) * 256 + cw, 512);
        } else {
            epi_store_act<2>(acc, (bf16_t*)(ws + WS_SMA) + (size_t)row0 * 1024 + (u.pn - 20) * 256 + cw, 1024);
        }
    } else if (u.id == 2 || u.id == 3) {
        bf16_t* yp = (bf16_t*)(ws + WS_SMC) + (size_t)row0 * 1024 + u.pn * 256 + cw;
        const bf16_t* gp = (const bf16_t*)(ws + WS_SMA) + (size_t)row0 * 1024 + u.pn * 256 + cw;
        const bool second = (u.id == 3);
#pragma unroll
        for (int ai = 0; ai < 2; ++ai)
#pragma unroll
            for (int m = 0; m < 4; ++m)
#pragma unroll
                for (int bj = 0; bj < 2; ++bj) {
                    const size_t off = (size_t)(ai * 128 + m * 16) * 1024 + bj * 128;
                    const u32x4 y = *(const u32x4*)(yp + off);
                    const f32x4 v0 = acc[ai][bj][m][0], v1 = acc[ai][bj][m][1];
                    float r[8];
                    if (second) {
                        const u32x4 g = *(const u32x4*)(gp + off);
                        r[0] = bf_lo(y.x) + bf_lo(g.x) * v0[0]; r[1] = bf_hi(y.x) + bf_hi(g.x) * v0[1]; r[2] = bf_lo(y.y) + bf_lo(g.y) * v0[2]; r[3] = bf_hi(y.y) + bf_hi(g.y) * v0[3];
                        r[4] = bf_lo(y.z) + bf_lo(g.z) * v1[0]; r[5] = bf_hi(y.z) + bf_hi(g.z) * v1[1]; r[6] = bf_lo(y.w) + bf_lo(g.w) * v1[2]; r[7] = bf_hi(y.w) + bf_hi(g.w) * v1[3];
                    } else {
                        r[0] = bf_lo(y.x) * v0[0]; r[1] = bf_hi(y.x) * v0[1]; r[2] = bf_lo(y.y) * v0[2]; r[3] = bf_hi(y.y) * v0[3];
                        r[4] = bf_lo(y.z) * v1[0]; r[5] = bf_hi(y.z) * v1[1]; r[6] = bf_lo(y.w) * v1[2]; r[7] = bf_hi(y.w) * v1[3];
                    }
                    u32x4 w; w.x = cvt_pk_bf16(r[0], r[1]); w.y = cvt_pk_bf16(r[2], r[3]); w.z = cvt_pk_bf16(r[4], r[5]); w.w = cvt_pk_bf16(r[6], r[7]);
                    *(u32x4*)(yp + off) = w;
                }
    } else {
        const int b = u.pm >> 4;
        const float* gate = (const float*)(ws + WS_MOD) + b * 3072 + 2048 + u.pn * 256 + cw;
        const float* xp = P.x + (size_t)row0 * 1024 + u.pn * 256 + cw;
        float* op = P.out + (size_t)row0 * 1024 + u.pn * 256 + cw;
#pragma unroll
        for (int bj = 0; bj < 2; ++bj) {
            const f32x4 g0 = *(const f32x4*)(gate + bj * 128), g1 = *(const f32x4*)(gate + bj * 128 + 4);
#pragma unroll
            for (int ai = 0; ai < 2; ++ai)
#pragma unroll
                for (int m = 0; m < 4; ++m) {
                    const size_t off = (size_t)(ai * 128 + m * 16) * 1024 + bj * 128;
                    const f32x4 x0 = __builtin_nontemporal_load((const f32x4*)(xp + off)), x1 = __builtin_nontemporal_load((const f32x4*)(xp + off + 4));
                    __builtin_nontemporal_store(x0 + g0 * acc[ai][bj][m][0], (f32x4*)(op + off));
                    __builtin_nontemporal_store(x1 + g1 * acc[ai][bj][m][1], (f32x4*)(op + off + 4));
                }
        }
    }
}

namespace pg8 {
__device__ __forceinline__ void gemm_phase(const Params& P, LAS unsigned char* lds, const int K, const Sched2& S) {
    int tid = threadIdx.x; asm volatile("" : "+v"(tid));
    const int wid = __builtin_amdgcn_readfirstlane(tid >> 6), lane = tid & 63, wr = wid >> 2, wc = wid & 3, fr = lane & 15, fq = lane >> 4;
    const int nt = K / BK;
    unsigned voffA[2], voffB[2];
#pragma unroll
    for (int i = 0; i < 2; ++i) { int R, C; stage_rc(tid * 16 + i * 8192, R, C); const int Rb = (R & ~31) + perm32(R & 31);
        voffA[i] = (unsigned)(R * K + C) * 2u; voffB[i] = (unsigned)(Rb * K + C) * 2u; }
    const size_t kstep = (size_t)(BK * 2);
    const size_t hstep = (size_t)HALF * K * 2;
    const size_t tstep = 2 * hstep;
    const unsigned ldsw = (unsigned)wid * 1024u;
    const int aoff = lds_byte(wr * 64 + fr, fq * 8), boff = lds_byte(wc * 32 + fr, fq * 8);
#define PG8_SA(b, h) (((b) * 2 + (h)) * HTB)
#define PG8_SB(b, h) ((4 + (b) * 2 + (h)) * HTB)
#define PG8_STAGE(bufoff, gbase, voff) do { _Pragma("unroll") for (int _i = 0; _i < 2; ++_i) \
        __builtin_amdgcn_global_load_lds((const unsigned*)((const char*)(gbase) + (voff)[_i]), (LAS unsigned*)(lds + (bufoff) + ldsw + _i * 8192), 16, 0, 0); } while (0)
#define PG8_LDA(dst, b, h) do { _Pragma("unroll") for (int m = 0; m < 4; ++m) _Pragma("unroll") for (int k = 0; k < 2; ++k) dst[m][k] = *(const LAS bf16x8*)(lds + PG8_SA(b, h) + aoff + m * 2048 + k * 1024); } while (0)
#define PG8_LDB(dst, b, h) do { _Pragma("unroll") for (int n = 0; n < 2; ++n) _Pragma("unroll") for (int k = 0; k < 2; ++k) dst[n][k] = *(const LAS bf16x8*)(lds + PG8_SB(b, h) + boff + n * 2048 + k * 1024); } while (0)
#define PG8_MMA(ai, bj, At, Bt) do { __builtin_amdgcn_s_setprio(1); _Pragma("unroll") for (int m = 0; m < 4; ++m) _Pragma("unroll") for (int n = 0; n < 2; ++n) _Pragma("unroll") for (int k = 0; k < 2; ++k) \
        acc[ai][bj][m][n] = __builtin_amdgcn_mfma_f32_16x16x32_bf16(Bt[n][k], At[m][k], acc[ai][bj][m][n], 0, 0, 0); __builtin_amdgcn_s_setprio(0); } while (0)
#define PG8_WAIT_V(n) asm volatile("s_waitcnt vmcnt(" #n ")" ::: "memory")
#define PG8_WAIT_L(n) asm volatile("s_waitcnt lgkmcnt(" #n ")" ::: "memory")
#define PG8_BAR __builtin_amdgcn_s_barrier()
#define PG8_SCHED __builtin_amdgcn_sched_barrier(0)
    Unit cur, nxt; int ui = 0;
    if (!S.next(0, cur)) return;
    f32x4 acc[2][2][4][2];
#pragma unroll
    for (int a = 0; a < 2; ++a)
#pragma unroll
        for (int b = 0; b < 2; ++b)
#pragma unroll
            for (int m = 0; m < 4; ++m)
#pragma unroll
                for (int n = 0; n < 2; ++n) acc[a][b][m][n] = (f32x4){0.f, 0.f, 0.f, 0.f};
    bf16x8 At[4][2], B0[2][2], B1[2][2];
    const char* cA = (const char*)P.ws + a_off(cur.id) + (size_t)cur.pm * tstep; const char* cB = (const char*)P.ws + b_off(cur.id) + (size_t)cur.pn * tstep;
    PG8_STAGE(PG8_SB(0, 0), cB, voffB); PG8_STAGE(PG8_SB(0, 1), cB + hstep, voffB); PG8_STAGE(PG8_SA(0, 0), cA, voffA); PG8_STAGE(PG8_SA(0, 1), cA + hstep, voffA);
    if (wr == 1) PG8_BAR;
    PG8_WAIT_V(2); PG8_BAR;
    PG8_STAGE(PG8_SB(1, 0), cB + kstep, voffB); PG8_STAGE(PG8_SA(1, 0), cA + kstep, voffA); PG8_STAGE(PG8_SB(1, 1), cB + hstep + kstep, voffB);
    PG8_WAIT_V(6); PG8_BAR;
    for (;;) {
        const bool has_next = S.next(ui + 1, nxt);
        const char* nA = has_next ? (const char*)P.ws + a_off(nxt.id) + (size_t)nxt.pm * tstep : cA; const char* nB = has_next ? (const char*)P.ws + b_off(nxt.id) + (size_t)nxt.pn * tstep : cB;
        for (int t = 0; t < nt; t += 2) {
            const bool last = (t == nt - 2);
            const char* a1 = cA + (size_t)(t + 1) * kstep;
            const char* a2 = last ? nA : cA + (size_t)(t + 2) * kstep; const char* b2 = last ? nB : cB + (size_t)(t + 2) * kstep;
            const char* a3 = a2 + kstep; const char* b3 = b2 + kstep;
            PG8_LDB(B0, 0, 0); PG8_LDB(B1, 0, 1); PG8_SCHED; PG8_LDA(At, 0, 0); PG8_STAGE(PG8_SA(1, 1), a1 + hstep, voffA);
            PG8_WAIT_V(8); PG8_WAIT_L(0); PG8_BAR; PG8_MMA(0, 0, At, B0); PG8_MMA(0, 1, At, B1); PG8_BAR; PG8_SCHED;
            PG8_LDA(At, 0, 1); PG8_STAGE(PG8_SB(0, 0), b2, voffB); PG8_STAGE(PG8_SB(0, 1), b2 + hstep, voffB); PG8_STAGE(PG8_SA(0, 0), a2, voffA);
            PG8_WAIT_V(8); PG8_WAIT_L(0); PG8_BAR; PG8_MMA(1, 0, At, B0); PG8_MMA(1, 1, At, B1); PG8_BAR; PG8_SCHED;
            PG8_LDB(B0, 1, 0); PG8_LDB(B1, 1, 1); PG8_SCHED; PG8_LDA(At, 1, 0); PG8_STAGE(PG8_SA(0, 1), a2 + hstep, voffA);
            PG8_WAIT_V(8); PG8_WAIT_L(0); PG8_BAR; PG8_MMA(0, 0, At, B0); PG8_MMA(0, 1, At, B1); PG8_BAR; PG8_SCHED;
            PG8_LDA(At, 1, 1); PG8_STAGE(PG8_SB(1, 0), b3, voffB); PG8_STAGE(PG8_SB(1, 1), b3 + hstep, voffB); PG8_STAGE(PG8_SA(1, 0), a3, voffA);
            PG8_WAIT_V(8); PG8_WAIT_L(0); PG8_BAR; PG8_MMA(1, 0, At, B0); PG8_MMA(1, 1, At, B1); PG8_BAR; PG8_SCHED;
        }
        if (wr == 0) PG8_BAR;
        epilogue(P, acc, cur, wr, wc, fr, fq, lds);
        if (!has_next) break;
#pragma unroll
        for (int a = 0; a < 2; ++a)
#pragma unroll
            for (int b = 0; b < 2; ++b)
#pragma unroll
                for (int m = 0; m < 4; ++m)
#pragma unroll
                    for (int n = 0; n < 2; ++n) acc[a][b][m][n] = (f32x4){0.f, 0.f, 0.f, 0.f};
        cur = nxt; cA = nA; cB = nB; ++ui;
        if (wr == 1) PG8_BAR;
    }
    PG8_WAIT_V(0);
    PG8_BAR;
#undef PG8_SA
#undef PG8_SB
#undef PG8_STAGE
#undef PG8_LDA
#undef PG8_LDB
#undef PG8_MMA
#undef PG8_WAIT_V
#undef PG8_WAIT_L
#undef PG8_BAR
#undef PG8_SCHED
}
}

constexpr int P0_CHUNKS = 640;
template <bool PERMW> __device__ __forceinline__ void p0_transpose(const float* __restrict__ W, int ldw, int Kd, bf16_t* __restrict__ WT, int chunk0, int nchunks, int kshift, int tid, int bid, int G) {
    const int nn = tid & 63, k8 = tid >> 6;
#pragma unroll 4
    for (int it = chunk0 + bid; it < nchunks; it += G) {
        const int ntile = it >> kshift, kt = it & ((1 << kshift) - 1);
        const int np = ntile * 64 + nn;
        const int col = PERMW ? col_of(np) : np;
        const float* src = W + (size_t)(kt * 64 + k8 * 8) * ldw + col;
        float v[8];
#pragma unroll
        for (int e = 0; e < 8; ++e) v[e] = src[(size_t)e * ldw];
        u32x4 w; w.x = cvt_pk_bf16(v[0], v[1]); w.y = cvt_pk_bf16(v[2], v[3]); w.z = cvt_pk_bf16(v[4], v[5]); w.w = cvt_pk_bf16(v[6], v[7]);
        *(u32x4*)(WT + (size_t)np * Kd + kt * 64 + k8 * 8) = w;
    }
}

__device__ __forceinline__ void p0_prep(const Params& P, LAS unsigned char* lds) {
    const int tid = threadIdx.x, bid = blockIdx.x, G = gridDim.x;
    unsigned char* ws = P.ws;
    if (bid < 96) {
        LAS float* sc = (LAS float*)(lds + 32768);
        LAS float* red = (LAS float*)(lds + 65536);
        for (int i = tid; i < 8192; i += 512) sc[i] = siluf_(P.c[i]);
        __syncthreads();
        const int cl = tid & 31, kg = tid >> 5, col = bid * 32 + cl;
        float a[8];
#pragma unroll
        for (int b = 0; b < 8; ++b) a[b] = 0.f;
#pragma unroll
        for (int kb = 0; kb < 4; ++kb) {
            float w[16];
#pragma unroll
            for (int i = 0; i < 16; ++i) w[i] = P.w_ada[(size_t)(kg * 64 + kb * 16 + i) * 3072 + col];
#pragma unroll
            for (int i = 0; i < 16; ++i)
#pragma unroll
                for (int b = 0; b < 8; ++b) a[b] += sc[b * 1024 + kg * 64 + kb * 16 + i] * w[i];
        }
#pragma unroll
        for (int b = 0; b < 8; ++b) red[(kg * 8 + b) * 32 + cl] = a[b];
        __syncthreads();
        if (tid < 256) {
            const int b = tid >> 5; float s = 0.f;
#pragma unroll
            for (int g = 0; g < 16; ++g) s += red[(g * 8 + b) * 32 + cl];
            __hip_atomic_store((float*)(ws + WS_MOD) + b * 3072 + col, s + P.b_ada[col], __ATOMIC_RELAXED, __HIP_MEMORY_SCOPE_AGENT);
        }
        asm volatile("s_waitcnt vmcnt(0)" ::: "memory");
        __syncthreads();
        if (tid == 0) __hip_atomic_fetch_add((unsigned*)(ws + WS_CTL) + 192, 1u, __ATOMIC_RELAXED, __HIP_MEMORY_SCOPE_AGENT);
    }
    else if (G > 96) {
        p0_transpose<true>(P.w_in, 10240, 1024, (bf16_t*)(ws + WS_WIN), 0, P0_CHUNKS, 4, tid, bid - 96, G - 96);
    }
}
__device__ __forceinline__ void p0_rest(const Params& P) {
    const int tid = threadIdx.x, bid = blockIdx.x, G = gridDim.x;
    unsigned char* ws = P.ws;
    p0_transpose<true>(P.w_in, 10240, 1024, (bf16_t*)(ws + WS_WIN), (G > 96) ? P0_CHUNKS : 0, 2560, 4, tid, bid, G);
    p0_transpose<false>(P.w_conv_out, 1024, 1024, (bf16_t*)(ws + WS_WC), 0, 256, 4, tid, bid, G);
    p0_transpose<false>(P.w_attn_out, 1024, 512, (bf16_t*)(ws + WS_WA), 0, 128, 3, tid, bid, G);
    p0_transpose<false>(P.w_out, 1024, 1024, (bf16_t*)(ws + WS_WO), 0, 256, 4, tid, bid, G);
}

__device__ __forceinline__ f32x4 ld_agent4(const float* p) {
    const unsigned long long a = __hip_atomic_load((const unsigned long long*)p, __ATOMIC_RELAXED, __HIP_MEMORY_SCOPE_AGENT);
    const unsigned long long b = __hip_atomic_load((const unsigned long long*)(p + 2), __ATOMIC_RELAXED, __HIP_MEMORY_SCOPE_AGENT);
    return (f32x4){__builtin_bit_cast(float, (unsigned)a), __builtin_bit_cast(float, (unsigned)(a >> 32)), __builtin_bit_cast(float, (unsigned)b), __builtin_bit_cast(float, (unsigned)(b >> 32))};
}
__device__ __forceinline__ void p0b_h(const Params& P) {
    const int tid = threadIdx.x, lane = tid & 63, wid = tid >> 6;
    const float* mod = (const float*)(P.ws + WS_MOD);
    bf16_t* H = (bf16_t*)(P.ws + WS_H);
    if (threadIdx.x == 0) { while (__hip_atomic_load((unsigned*)(P.ws + WS_CTL) + 192, __ATOMIC_RELAXED, __HIP_MEMORY_SCOPE_AGENT) < 96u) __builtin_amdgcn_s_sleep(1); }
    __syncthreads();
    const int nw = gridDim.x * 8, gw = blockIdx.x * 8 + wid;
    const int rpw = T / nw;
    const int rbeg = gw * rpw, b = rbeg >> 12;
    f32x4 mul[4], add[4];
#pragma unroll
    for (int i = 0; i < 4; ++i) {
        const int idx = i * 256 + lane * 4;
        const f32x4 nwv = *(const f32x4*)(P.norm_w + idx), sh = ld_agent4(mod + b * 3072 + idx), sc = ld_agent4(mod + b * 3072 + 1024 + idx);
        mul[i] = nwv * (sc + 1.0f); add[i] = sh;
    }
    for (int r = rbeg; r < rbeg + rpw; r += 4) {
        f32x4 v[4][4]; float ss[4];
#pragma unroll
        for (int q = 0; q < 4; ++q)
#pragma unroll
            for (int i = 0; i < 4; ++i) v[q][i] = __builtin_nontemporal_load((const f32x4*)(P.x + (size_t)(r + q) * 1024 + i * 256 + lane * 4));
#pragma unroll
        for (int q = 0; q < 4; ++q) {
            float s = 0.f;
#pragma unroll
            for (int i = 0; i < 4; ++i) s += (v[q][i][0] * v[q][i][0] + v[q][i][1] * v[q][i][1]) + (v[q][i][2] * v[q][i][2] + v[q][i][3] * v[q][i][3]);
            ss[q] = wave_sum(s);
        }
#pragma unroll
        for (int q = 0; q < 4; ++q) {
            const float rs = __builtin_amdgcn_rsqf(ss[q] * (1.0f / 1024.0f) + EPS);
#pragma unroll
            for (int i = 0; i < 4; ++i) {
                const f32x4 h = (v[q][i] * rs) * mul[i] + add[i];
                u32x2 w; w.x = cvt_pk_bf16(h[0], h[1]); w.y = cvt_pk_bf16(h[2], h[3]);
                *(u32x2*)(H + (size_t)(r + q) * 1024 + i * 256 + lane * 4) = w;
            }
        }
    }
}

__device__ __forceinline__ void p2_conv(const Params& P, LAS unsigned char* lds) {
    int tid = threadIdx.x; asm volatile("" : "+v"(tid));
    const int lane = tid & 63, wid = tid >> 6, G = gridDim.x, bid = blockIdx.x;
    const bf16_t* U = (const bf16_t*)(P.ws + WS_U);
    const bf16_t* SGC = (const bf16_t*)(P.ws + WS_SGC);
    bf16_t* A2 = (bf16_t*)(P.ws + WS_A2);
    LAS float* st = (LAS float*)(lds + RING_BYTES);
    LAS float* tot = (LAS float*)(lds + RING_BYTES + 2048);
    const int ch = 2 * tid;
    f32x2 cw[31];
#pragma unroll
    for (int j = 0; j < 31; ++j) cw[j] = *(const f32x2*)(P.conv_w + j * 1024 + ch);
    const f32x2 cb = *(const f32x2*)(P.conv_b + ch), lw = *(const f32x2*)(P.ln_w + ch), lb = *(const f32x2*)(P.ln_b + ch);
    constexpr int NT = T / 16, NCH = 46 * 128;
    const int t0 = (int)((long)NT * bid / G), t1 = (int)((long)NT * (bid + 1) / G);
    u32x4 tv[6];
#define CONV_LOAD(TILE, HB) do { const int _r0 = (TILE) * 16, _s0 = _r0 & (SEQ - 1); _Pragma("unroll") for (int _it = 0; _it < 6; ++_it) { \
        int _i = tid + ((HB) * 6 + _it) * 512; if (_i > NCH - 1) _i = NCH - 1; const int _row = _i >> 7, _c16 = _i & 127; \
        int _sr = _r0 - 30 + _row; if (_s0 - 30 + _row < 0) _sr = _r0; tv[_it] = *(const u32x4*)(U + (size_t)_sr * 1024 + _c16 * 8); } } while (0)
#define CONV_WRITE(TILE, HB) do { const int _s0 = ((TILE) * 16) & (SEQ - 1); _Pragma("unroll") for (int _it = 0; _it < 6; ++_it) { \
        const int _i = tid + ((HB) * 6 + _it) * 512; const int _row = _i >> 7, _c16 = _i & 127; u32x4 _v = tv[_it]; \
        if (_s0 - 30 + _row < 0) _v = (u32x4){0u, 0u, 0u, 0u}; if (_i < NCH) *(LAS u32x4*)(lds + _row * 2048 + _c16 * 16) = _v; } } while (0)
    if (t0 < t1) { CONV_LOAD(t0, 0); CONV_WRITE(t0, 0); CONV_LOAD(t0, 1); CONV_WRITE(t0, 1); }
    for (int tile = t0; tile < t1; ++tile) {
        const bool has_next = tile + 1 < t1;
        __syncthreads();
#pragma unroll
        for (int g = 0; g < 2; ++g) {
            const int r0 = tile * 16 + g * 8;
            const bool pre = has_next && g == 1;
            f32x2 a[8];
            {
                f32x2 uin[38];
#pragma unroll
                for (int i = 0; i < 38; ++i) { const unsigned w = *(const LAS unsigned*)(lds + (g * 8 + i) * 2048 + tid * 4); uin[i] = (f32x2){bf_lo(w), bf_hi(w)}; }
#pragma unroll
                for (int r = 0; r < 8; ++r) {
                    f32x2 v = cb;
#pragma unroll
                    for (int j = 0; j < 31; ++j) v += cw[j] * uin[r + j];
                    a[r] = v;
                }
            }
            {
                float sv[16];
#pragma unroll
                for (int r = 0; r < 8; ++r) { sv[2 * r] = a[r][0] + a[r][1]; sv[2 * r + 1] = a[r][0] * a[r][0] + a[r][1] * a[r][1]; }
#define BFLY(HALF, BIT) do { const bool up = (lane & (BIT)) != 0; _Pragma("unroll") for (int i = 0; i < (HALF); ++i) { \
                const float keep = up ? sv[i + (HALF)] : sv[i], send = up ? sv[i] : sv[i + (HALF)]; sv[i] = keep + __shfl_xor(send, (BIT)); } } while (0)
#define BFLYP(HALF, BIT, XP) do { const bool up = (lane & (BIT)) != 0; _Pragma("unroll") for (int i = 0; i < (HALF); ++i) { \
                const float keep = up ? sv[i + (HALF)] : sv[i], send = up ? sv[i] : sv[i + (HALF)]; sv[i] = keep + XP(send, lane); } } while (0)
                BFLYP(8, 32, xpartner32); BFLYP(4, 16, xpartner16); BFLY(2, 8); BFLY(1, 4);
#undef BFLYP
#undef BFLY
                float v = sv[0]; v += __shfl_xor(v, 2); v += __shfl_xor(v, 1);
                if ((lane & 3) == 0) st[wid * 16 + (lane >> 2)] = v;
            }
            __syncthreads();
            if (pre) CONV_LOAD(tile + 1, 0);
            if (tid < 16) { float s = 0.f;
#pragma unroll
                for (int w = 0; w < 8; ++w) s += st[w * 16 + tid];
                tot[tid] = s; }
            unsigned gw[8];
#pragma unroll
            for (int r = 0; r < 8; ++r) gw[r] = *(const unsigned*)(SGC + (size_t)(r0 + r) * 1024 + ch);
            __syncthreads();
            if (pre) { CONV_WRITE(tile + 1, 0); CONV_LOAD(tile + 1, 1); }
#pragma unroll
            for (int r = 0; r < 8; ++r) {
                const f32x2 t2 = *(const LAS f32x2*)(tot + 2 * r);
                const float mu = t2[0] * (1.0f / 1024.0f), var = t2[1] * (1.0f / 1024.0f) - mu * mu;
                const float rstd = __builtin_amdgcn_rsqf(fmaxf(var, 0.f) + EPS);
                const float y0 = siluf_((a[r][0] - mu) * rstd * lw[0] + lb[0]) * bf_lo(gw[r]);
                const float y1 = siluf_((a[r][1] - mu) * rstd * lw[1] + lb[1]) * bf_hi(gw[r]);
                *(unsigned*)(A2 + (size_t)(r0 + r) * 1024 + ch) = cvt_pk_bf16(y0, y1);
            }
            if (pre) CONV_WRITE(tile + 1, 1);
        }
    }
#undef CONV_LOAD
#undef CONV_WRITE
}

__device__ __forceinline__ s16x4 vtr(LAS unsigned char* p) { return __builtin_bit_cast(s16x4, __builtin_amdgcn_ds_read_tr16_b64_v4i16((LAS s16x4*)p)); }

struct AItem { int g, d, b, head, r, n, chain; };
__device__ __forceinline__ AItem adecode(int I) {
    AItem it; it.g = I >> 10; const int rem = I & 1023, bh = rem >> 5, w = rem & 31;
    it.d = 1 << (2 * it.g); const int sh = 5 - 2 * it.g;
    it.r = w >> sh; it.n = w & ((1 << sh) - 1); it.b = bh >> 2; it.head = it.g * 4 + (bh & 3); it.chain = I >> sh; return it;
}

__device__ __forceinline__ void attn_compute(LAS unsigned char* lds, const int par, const AItem& cur, const bf16x8 (&qf)[4], bf16_t* Op, float* LSE, const int wid, const int c, const int fq) {
        f32x4 sacc[9];
#pragma unroll
        for (int tau = 0; tau < 9; ++tau) {
            const int kt = wid + tau;
            const unsigned kb = (unsigned)((((kt >> 3) ^ par) * 32768) + ((kt & 7) * 16 + c) * 256);
            f32x4 a = (f32x4){0.f, 0.f, 0.f, 0.f};
#pragma unroll
            for (int s = 0; s < 4; ++s) {
                const bf16x8 kf = *(const LAS bf16x8*)(lds + kb + ((((4 * s + fq) ^ c)) << 4));
                a = __builtin_amdgcn_mfma_f32_16x16x32_bf16(kf, qf[s], a, 0, 0, 0);
            }
            sacc[tau] = a;
        }
        float mx = -INFINITY;
#pragma unroll
        for (int tau = 0; tau < 9; ++tau)
#pragma unroll
            for (int jj = 0; jj < 4; ++jj) {
                const int rel = 16 * tau + 4 * fq + jj - c;
                const bool valid = (rel >= 0) && (rel <= 128) && ((cur.n > 0) || (wid + tau >= 8));
                const float s = valid ? sacc[tau][jj] : -INFINITY;
                sacc[tau][jj] = s; mx = fmaxf(mx, s);
            }
        mx = fmaxf(mx, __shfl_xor(mx, 16)); mx = fmaxf(mx, __shfl_xor(mx, 32));
        float lsum = 0.f;
#pragma unroll
        for (int tau = 0; tau < 9; ++tau)
#pragma unroll
            for (int jj = 0; jj < 4; ++jj) { const float p = fast_exp2(sacc[tau][jj] - mx); sacc[tau][jj] = p; lsum += p; }
        lsum += __shfl_xor(lsum, 16); lsum += __shfl_xor(lsum, 32);
        bf16x8 pb[5];
#pragma unroll
        for (int s5 = 0; s5 < 5; ++s5) {
            const f32x4 pa = sacc[2 * s5];
            f32x4 pc = (f32x4){0.f, 0.f, 0.f, 0.f};
            if (s5 < 4) pc = sacc[2 * s5 + 1];
            u32x4 w; w.x = cvt_pk_bf16(pa[0], pa[1]); w.y = cvt_pk_bf16(pa[2], pa[3]); w.z = cvt_pk_bf16(pc[0], pc[1]); w.w = cvt_pk_bf16(pc[2], pc[3]);
            pb[s5] = __builtin_bit_cast(bf16x8, w);
        }
        f32x4 oacc[8];
#pragma unroll
        for (int mt = 0; mt < 8; ++mt) oacc[mt] = (f32x4){0.f, 0.f, 0.f, 0.f};
        const int q4 = c >> 2, p4 = c & 3;
        const int krow = 4 * fq + q4, k7 = krow & 7;
#pragma unroll
        for (int s5 = 0; s5 < 5; ++s5) {
            const int kta = wid + 2 * s5; int ktb = wid + 2 * s5 + 1; if (ktb > 15) ktb = 15;
            LAS unsigned char* ba = lds + 65536 + ((((kta >> 3) ^ par) * 32768) + ((kta & 7) * 16 + krow) * 256 + 8 * (p4 & 1));
            LAS unsigned char* bb = lds + 65536 + ((((ktb >> 3) ^ par) * 32768) + ((ktb & 7) * 16 + krow) * 256 + 8 * (p4 & 1));
#pragma unroll
            for (int mt = 0; mt < 8; ++mt) {
                const int chs = ((2 * mt + (p4 >> 1)) ^ (k7 << 1)) << 4;
                const s16x4 va = vtr(ba + chs), vb = vtr(bb + chs);
                const bf16x8 af = (bf16x8){va[0], va[1], va[2], va[3], vb[0], vb[1], vb[2], vb[3]};
                oacc[mt] = __builtin_amdgcn_mfma_f32_16x16x32_bf16(af, pb[s5], oacc[mt], 0, 0, 0);
            }
        }
        {
            const float inv = fast_rcp(lsum);
            const size_t tq = (size_t)cur.b * SEQ + (size_t)(cur.n * 128 + wid * 16 + c) * cur.d + cur.r;
            bf16_t* orow = Op + ((size_t)(cur.b * 12 + cur.head) * SEQ + (size_t)cur.r * (SEQ / cur.d) + cur.n * 128 + wid * 16 + c) * 128 + 4 * fq;
#pragma unroll
            for (int mt = 0; mt < 8; ++mt) {
                u32x2 w; w.x = cvt_pk_bf16(oacc[mt][0] * inv, oacc[mt][1] * inv); w.y = cvt_pk_bf16(oacc[mt][2] * inv, oacc[mt][3] * inv);
                *(u32x2*)(orow + mt * 16) = w;
            }
            if (fq == 0) LSE[tq * 12 + cur.head] = mx + __builtin_amdgcn_logf(lsum);
        }
}

__device__ __forceinline__ void p4_attn(const Params& P, LAS unsigned char* lds) {
    int tid = threadIdx.x; asm volatile("" : "+v"(tid));
    const int lane = tid & 63, wid = __builtin_amdgcn_readfirstlane(tid >> 6), c = lane & 15, fq = lane >> 4;
    const bf16_t* Qp = (const bf16_t*)(P.ws + WS_Q); const bf16_t* Kp = (const bf16_t*)P.out; const bf16_t* Vp = (const bf16_t*)(P.ws + WS_V);
    bf16_t* Op = (bf16_t*)(P.ws + WS_Q); float* LSE = (float*)(P.ws + WS_LSE);
    const int G = gridDim.x, bid = blockIdx.x;
    const int i0 = (int)((long)3072 * bid / G), i1 = (int)((long)3072 * (bid + 1) / G);
    if (i0 >= i1) return;
    const int srow = tid >> 4, sch = tid & 15;
    u32x4 k0[4], v0[4], k1[4], v1[4]; bf16x8 qf[4], q0[4], q1[4];
#define LOAD_BLOCK(KR, VR, IT, NBLK) do { _Pragma("unroll") for (int _i = 0; _i < 4; ++_i) { const int _row = srow + 32 * _i; \
        const size_t _o = ((size_t)((IT).b * 12 + (IT).head) * SEQ + (size_t)(IT).r * (SEQ / (IT).d) + (NBLK) * 128 + _row) * 128 + sch * 8; \
        KR[_i] = *(const u32x4*)(Kp + _o); VR[_i] = *(const u32x4*)(Vp + _o); } } while (0)
#define ZERO_BLOCK(KR, VR) do { _Pragma("unroll") for (int _i = 0; _i < 4; ++_i) { KR[_i] = (u32x4){0u, 0u, 0u, 0u}; VR[_i] = (u32x4){0u, 0u, 0u, 0u}; } } while (0)
#define WRITE_BLOCK(KR, VR, SLOT) do { _Pragma("unroll") for (int _i = 0; _i < 4; ++_i) { const int _row = srow + 32 * _i; \
        *(LAS u32x4*)(lds + (SLOT) * 32768 + _row * 256 + ((sch ^ (_row & 15)) << 4)) = KR[_i]; \
        *(LAS u32x4*)(lds + 65536 + (SLOT) * 32768 + _row * 256 + ((sch ^ ((_row & 7) << 1)) << 4)) = VR[_i]; } } while (0)
#define LOAD_Q(DST, IT) do { const size_t _o = ((size_t)((IT).b * 12 + (IT).head) * SEQ + (size_t)(IT).r * (SEQ / (IT).d) + (IT).n * 128 + wid * 16 + c) * 128; \
        _Pragma("unroll") for (int _s = 0; _s < 4; ++_s) DST[_s] = *(const bf16x8*)(Qp + _o + _s * 32 + fq * 8); } while (0)
#define ATTN_ITEM(KL, VL, QL, KW, VW, QW) do { \
        if (I + 2 < i1) { const AItem n2 = adecode(I + 2); LOAD_BLOCK(KL, VL, n2, n2.n); LOAD_Q(QL, n2); } \
        attn_compute(lds, par, cur, qf, Op, LSE, wid, c, fq); \
        __syncthreads();                                             \
        if (I + 1 < i1) { const AItem nx = adecode(I + 1); \
            if (nx.chain == cur.chain) { WRITE_BLOCK(KW, VW, par); par ^= 1; }                \
            else { WRITE_BLOCK(KW, VW, par ^ 1); ZERO_BLOCK(KW, VW); WRITE_BLOCK(KW, VW, par); }     \
            _Pragma("unroll") for (int _s = 0; _s < 4; ++_s) qf[_s] = QW[_s]; \
            cur = nx; } \
        __syncthreads(); } while (0)

    AItem cur = adecode(i0);
    int par = 0;
    if (cur.n > 0) LOAD_BLOCK(k0, v0, cur, cur.n - 1); else ZERO_BLOCK(k0, v0);
    WRITE_BLOCK(k0, v0, 0);
    LOAD_BLOCK(k0, v0, cur, cur.n);
    WRITE_BLOCK(k0, v0, 1);
    LOAD_Q(qf, cur);
    if (i0 + 1 < i1) { const AItem n1 = adecode(i0 + 1); LOAD_BLOCK(k1, v1, n1, n1.n); LOAD_Q(q1, n1); }
    __syncthreads();
    for (int I = i0; I < i1; I += 2) {
        ATTN_ITEM(k0, v0, q0, k1, v1, q1);
        if (I + 1 < i1) { ++I; ATTN_ITEM(k1, v1, q1, k0, v0, q0); --I; }
    }
#undef ATTN_ITEM
#undef LOAD_BLOCK
#undef ZERO_BLOCK
#undef WRITE_BLOCK
#undef LOAD_Q
}

__device__ __forceinline__ void p5_combine(const Params& P) {
    const bf16_t* Op = (const bf16_t*)(P.ws + WS_Q); const float* LSE = (const float*)(P.ws + WS_LSE); bf16_t* SGA = (bf16_t*)(P.ws + WS_SGA);
    const long total = (long)T * 64;
#pragma unroll 4
    for (long i = (long)blockIdx.x * 512 + threadIdx.x; i < total; i += (long)gridDim.x * 512) {
        const long row = i >> 6; const int c8 = (int)(i & 63), hh = c8 >> 4, d8 = (c8 & 15) * 8;
        const float l0 = LSE[row * 12 + hh], l1 = LSE[row * 12 + 4 + hh], l2 = LSE[row * 12 + 8 + hh];
        const float M = fmaxf(l0, fmaxf(l1, l2));
        float w0 = fast_exp2(l0 - M), w1 = fast_exp2(l1 - M), w2 = fast_exp2(l2 - M);
        const float inv = fast_rcp(w0 + w1 + w2); w0 *= inv; w1 *= inv; w2 *= inv;
        const int bb = (int)(row >> 12), ss = (int)(row & (SEQ - 1));
        const u32x4 a = *(const u32x4*)(Op + qkv_off(bb, hh, ss) + d8), b = *(const u32x4*)(Op + qkv_off(bb, 4 + hh, ss) + d8), cc = *(const u32x4*)(Op + qkv_off(bb, 8 + hh, ss) + d8);
        const u32x4 g = *(const u32x4*)(SGA + row * 512 + hh * 128 + d8);
        u32x4 o;
#define CMB(F) { const float lo = (w0 * bf_lo(a.F) + w1 * bf_lo(b.F) + w2 * bf_lo(cc.F)) * bf_lo(g.F); const float hi = (w0 * bf_hi(a.F) + w1 * bf_hi(b.F) + w2 * bf_hi(cc.F)) * bf_hi(g.F); o.F = cvt_pk_bf16(lo, hi); }
        CMB(x) CMB(y) CMB(z) CMB(w)
#undef CMB
        *(u32x4*)(SGA + row * 512 + hh * 128 + d8) = o;
    }
}

extern __shared__ __attribute__((aligned(16))) unsigned char dyn_lds[];

__device__ __forceinline__ unsigned xcc_id() { return (unsigned)__builtin_amdgcn_s_getreg((3 << 11) | 20) & 0xFu; }
__device__ __forceinline__ void grid_seam(unsigned char* ws, LAS unsigned* sw  , const unsigned gen  , const unsigned G) {
    asm volatile("s_waitcnt vmcnt(0) lgkmcnt(0)" ::: "memory");
    __syncthreads();
    if (threadIdx.x == 0) {
        unsigned* ctl = (unsigned*)(ws + WS_CTL);
        unsigned* top = ctl + 64; unsigned* regtot = ctl + 128;
        const unsigned xcc = sw[2];
        const unsigned old = __hip_atomic_fetch_add(ctl + 256 + xcc * 64, 1u, __ATOMIC_RELAXED, __HIP_MEMORY_SCOPE_AGENT);
        unsigned nmine, nxcd;
        if (gen == 1u) {
            while (__hip_atomic_load(regtot, __ATOMIC_RELAXED, __HIP_MEMORY_SCOPE_AGENT) < G) __builtin_amdgcn_s_sleep(1);
            nmine = 0u; nxcd = 0u;
#pragma unroll
            for (int j = 0; j < 16; ++j) { const unsigned c = __hip_atomic_load(ctl + 2048 + j * 64, __ATOMIC_RELAXED, __HIP_MEMORY_SCOPE_AGENT); nxcd += (c != 0u); if ((unsigned)j == xcc) nmine = c; }
            sw[0] = nmine; sw[1] = nxcd;
        } else { nmine = sw[0]; nxcd = sw[1]; }
        if (old == nmine * gen - 1u) {
            __builtin_amdgcn_fence(__ATOMIC_RELEASE, "agent");
            asm volatile("s_waitcnt vmcnt(0)" ::: "memory");
            __hip_atomic_fetch_add(top, 1u, __ATOMIC_RELAXED, __HIP_MEMORY_SCOPE_AGENT);
        }
        const unsigned target = nxcd * gen;
        while (__hip_atomic_load(top, __ATOMIC_RELAXED, __HIP_MEMORY_SCOPE_AGENT) < target) __builtin_amdgcn_s_sleep(1);
        __builtin_amdgcn_fence(__ATOMIC_ACQUIRE, "agent");
        asm volatile("s_waitcnt vmcnt(0)" ::: "memory");
    }
    __syncthreads();
}
#define GSYNC_CG() do { asm volatile("s_waitcnt vmcnt(0) lgkmcnt(0)" ::: "memory"); __syncthreads(); \
    if (threadIdx.x < 64) { __builtin_amdgcn_fence(__ATOMIC_RELEASE, "agent"); asm volatile("s_waitcnt vmcnt(0)" ::: "memory"); } \
    grid.sync(); \
    if (threadIdx.x < 64) { __builtin_amdgcn_fence(__ATOMIC_ACQUIRE, "agent"); asm volatile("s_waitcnt vmcnt(0)" ::: "memory"); } __syncthreads(); } while (0)
#define GSYNC(GEN) grid_seam(P.ws, (LAS unsigned*)(lds + RING_BYTES + 12288), (GEN), (unsigned)G)

__global__ void __launch_bounds__(512, 2) fwd_megakernel(Params P) {
    cg::grid_group grid = cg::this_grid();
    LAS unsigned char* lds = (LAS unsigned char*)dyn_lds;
    unsigned char* ws = P.ws;
    const int G = gridDim.x, bid = blockIdx.x;

    if (threadIdx.x == 0) {
        const unsigned myxcc = xcc_id();
        ((LAS unsigned*)(lds + RING_BYTES + 12288))[2] = myxcc;
        __hip_atomic_fetch_add((unsigned*)(ws + WS_CTL) + 2048 + myxcc * 64, 1u, __ATOMIC_RELAXED, __HIP_MEMORY_SCOPE_AGENT);
        asm volatile("s_waitcnt vmcnt(0)" ::: "memory");
        __hip_atomic_fetch_add((unsigned*)(ws + WS_CTL) + 128, 1u, __ATOMIC_RELAXED, __HIP_MEMORY_SCOPE_AGENT);
    }
    if (P.ws == nullptr) grid.sync();
    p0_prep(P, lds);
    p0_rest(P);
    p0b_h(P);
    GSYNC(1u);
    { pg8::Sched2 S; S.mode = 0; S.G = G; S.c = bid; pg8::gemm_phase(P, lds, 1024, S); }
    GSYNC(2u);
    p2_conv(P, lds);
    GSYNC(3u);
    { pg8::Sched2 S; S.mode = 1; S.G = G; S.c = bid; pg8::gemm_phase(P, lds, 1024, S); }
    GSYNC(4u);
    p4_attn(P, lds);
    GSYNC(5u);
    p5_combine(P);
    GSYNC(6u);
    { pg8::Sched2 S; S.mode = 2; S.G = G; S.c = bid; pg8::gemm_phase(P, lds, 512, S); }
    GSYNC(7u);
    { pg8::Sched2 S; S.mode = 3; S.G = G; S.c = bid; pg8::gemm_phase(P, lds, 1024, S); }
}

extern "C" void kernel_launch(void* const* d_in, const int* in_sizes, int n_in, void* d_out, int out_size, void* d_ws, size_t ws_size, hipStream_t stream) {
    static int grid = 0;
    if (grid == 0) {
        if (n_in != 16 || out_size != T * DM || ws_size < WS_END) { fprintf(stderr, "kernel_launch: unexpected shapes (n_in %d out %d ws %zu)\n", n_in, out_size, ws_size); grid = -1; return; }
        int dev = 0, cus = 0, per_cu = 0;
        if (hipGetDevice(&dev) != hipSuccess || hipDeviceGetAttribute(&cus, hipDeviceAttributeMultiprocessorCount, dev) != hipSuccess) { grid = -1; return; }
        if (hipFuncSetAttribute((const void*)fwd_megakernel, hipFuncAttributeMaxDynamicSharedMemorySize, LDS_BYTES) != hipSuccess) { fprintf(stderr, "kernel_launch: hipFuncSetAttribute failed\n"); grid = -1; return; }
        if (hipOccupancyMaxActiveBlocksPerMultiprocessor(&per_cu, (const void*)fwd_megakernel, 512, LDS_BYTES) != hipSuccess || per_cu < 1) { fprintf(stderr, "kernel_launch: occupancy query says %d\n", per_cu); (void)hipGetLastError(); }
        grid = cus;
    }
    if (grid < 0) return;
    Params p{};
    p.x = (const float*)d_in[0]; p.c = (const float*)d_in[1]; p.pos = (const int*)d_in[2]; p.norm_w = (const float*)d_in[3]; p.w_ada = (const float*)d_in[4]; p.b_ada = (const float*)d_in[5];
    p.w_in = (const float*)d_in[6]; p.conv_w = (const float*)d_in[7]; p.conv_b = (const float*)d_in[8]; p.ln_w = (const float*)d_in[9]; p.ln_b = (const float*)d_in[10]; p.w_conv_out = (const float*)d_in[11];
    p.qn_w = (const float*)d_in[12]; p.kn_w = (const float*)d_in[13]; p.w_attn_out = (const float*)d_in[14]; p.w_out = (const float*)d_in[15];
    p.out = (float*)d_out; p.ws = (unsigned char*)d_ws;
    if (hipMemsetAsync((unsigned char*)d_ws + WS_CTL, 0, CTL_BYTES, stream) != hipSuccess) { fprintf(stderr, "kernel_launch: memset failed\n"); return; }
    void* args[] = {&p};
    hipError_t e = hipLaunchCooperativeKernel((const void*)fwd_megakernel, dim3(grid), dim3(512), args, LDS_BYTES, stream);
    if (e != hipSuccess) fprintf(stderr, "kernel_launch: cooperative launch failed: %s (grid %d)\n", hipGetErrorString(e), grid);
}
```
